# Optimizing an MI355X kernel written in HIP

```python
import jax, jax.numpy as jnp
from jax import lax
import numpy as np


D_MODEL = 1024
BATCH = 2
SEQ = 8192
DEPTH = 2

GRID_W = 64
CTX_LEN = 256
N_MIXERS = 2
N_A_LAYERS = (DEPTH + N_MIXERS - 1) // N_MIXERS
N_B_LAYERS = DEPTH // N_MIXERS
POOL_WINDOWS = (2, 4, 8, 16)
POOL_GROUPS = 4
POOL_GROUP_DIM = D_MODEL // POOL_GROUPS
NA_HEADS = 16
NA_HEAD_DIM = D_MODEL // NA_HEADS
WIN_H = 8
WIN_W = 16
COL_BAND = 2 * WIN_W
D_FF = 2816
CONV_W = 3
ADA_CHUNKS = 6
EPS = 1e-6
NEG_INF = -1e30

kernel_name = 'hybrid_pool_natten_dit_block'


def rms_norm(x, g):
    x32 = x.astype(jnp.float32)
    y = x32 * lax.rsqrt(jnp.mean(x32 * x32, axis=-1, keepdims=True) + EPS)
    return (y * g.astype(jnp.float32)).astype(x.dtype)


def modulate(h, shift, scale):
    return h * (1 + scale) + shift


def ada_mods(cond, w, b):
    mods = (jax.nn.silu(cond) @ w + b)[..., None, :]
    return jnp.split(mods, ADA_CHUNKS, axis=-1)


def centred_window_mean(u, w):
    n = u.shape[1]
    u32 = u.astype(jnp.float32)
    cs = jnp.concatenate([jnp.zeros_like(u32[:, :1]), jnp.cumsum(u32, axis=1)], axis=1)
    t = jnp.arange(n)
    lo = jnp.maximum(t - w // 2, 0)
    hi = jnp.minimum(t + w // 2, n)
    cnt = (hi - lo).astype(jnp.float32)
    return ((cs[:, hi] - cs[:, lo]) / cnt[None, :, None]).astype(u.dtype)


def pool_mixer(u, w_groups, scale):
    outs = []
    for g, win in enumerate(POOL_WINDOWS):
        ug = u[..., g * POOL_GROUP_DIM:(g + 1) * POOL_GROUP_DIM]
        outs.append((centred_window_mean(ug, win) - ug) @ w_groups[g])
    return jnp.concatenate(outs, axis=-1) * scale


def depthwise_conv(h, w, b):
    n = h.shape[1]
    p = CONV_W // 2
    hp = jnp.pad(h, ((0, 0), (p, p), (0, 0)))
    out = b
    for j in range(CONV_W):
        out = out + hp[:, j:j + n] * w[j]
    return out


def conv_ffn(u, w_up, conv_w, conv_b, w_down):
    h = depthwise_conv(u @ w_up, conv_w, conv_b)
    gate, val = jnp.split(h, 2, axis=-1)
    return (jax.nn.gelu(gate) * val) @ w_down


def column_band_tables():
    n_cb = GRID_W // WIN_W
    qcol = np.arange(GRID_W).reshape(n_cb, WIN_W)
    band_start = np.clip(np.arange(n_cb) * WIN_W - WIN_W // 2, 0, GRID_W - COL_BAND)
    band = band_start[:, None] + np.arange(COL_BAND)[None]
    win_start = np.clip(qcol - WIN_W // 2, 0, GRID_W - WIN_W)
    kc = band[:, None, :]
    valid = (kc >= win_start[..., None]) & (kc < win_start[..., None] + WIN_W)
    dc = np.clip(kc - qcol[..., None] + WIN_W - 1, 0, 2 * WIN_W - 2)
    return band, valid, dc


def split_heads(t, n_parts):
    bsz, n, _ = t.shape
    t = t.reshape(bsz, n, n_parts, NA_HEADS, NA_HEAD_DIM)
    return [jnp.transpose(t[:, :, j], (0, 2, 1, 3)) for j in range(n_parts)]


def context_self_attention(uc, w_qkv, w_o):
    bsz, m, _ = uc.shape
    q_c, k_c, v_c = split_heads(uc @ w_qkv, 3)
    s = jnp.einsum('bhqd,bhkd->bhqk', q_c, k_c).astype(jnp.float32) * (NA_HEAD_DIM ** -0.5)
    p = jax.nn.softmax(s, axis=-1).astype(v_c.dtype)
    o = jnp.einsum('bhqk,bhkd->bhqd', p, v_c)
    return jnp.transpose(o, (0, 2, 1, 3)).reshape(bsz, m, D_MODEL) @ w_o


def neighbourhood_attention(u, uc, w_qkv, w_o, rpb):
    bsz, n, _ = u.shape
    rows = n // GRID_W
    kh = min(WIN_H, rows)
    n_cb = GRID_W // WIN_W
    nk = kh * COL_BAND
    scale = NA_HEAD_DIM ** -0.5
    band, valid, dc = column_band_tables()
    band_idx = jnp.asarray(band)
    col_valid = jnp.asarray(valid)
    dc_idx = jnp.asarray(dc)

    q, k, v = [t.reshape(bsz, NA_HEADS, rows, GRID_W, NA_HEAD_DIM) for t in split_heads(u @ w_qkv, 3)]
    k_c, v_c = split_heads(uc @ w_qkv[:, D_MODEL:], 2)

    def row_block(r):
        s0 = jnp.clip(r - kh // 2, 0, rows - kh)
        q_r = lax.dynamic_index_in_dim(q, r, axis=2, keepdims=False)
        q_r = q_r.reshape(bsz, NA_HEADS, n_cb, WIN_W, NA_HEAD_DIM)

        def gather_band(t):
            t_r = lax.dynamic_slice_in_dim(t, s0, kh, axis=2)
            t_b = t_r[:, :, :, band_idx]
            return jnp.moveaxis(t_b, 3, 2).reshape(bsz, NA_HEADS, n_cb, nk, NA_HEAD_DIM)

        k_b, v_b = gather_band(k), gather_band(v)
        dr_idx = s0 + jnp.arange(kh) - r + WIN_H - 1
        bias = rpb[:, dr_idx[:, None, None, None], dc_idx[None]]
        bias = jnp.where(col_valid[None, None], bias.astype(jnp.float32), NEG_INF)
        bias = jnp.moveaxis(bias, 1, 3).reshape(NA_HEADS, n_cb, WIN_W, nk)
        s_lat = jnp.einsum('bhnqd,bhnkd->bhnqk', q_r, k_b).astype(jnp.float32) * scale + bias
        s_ctx = jnp.einsum('bhnqd,bhcd->bhnqc', q_r, k_c).astype(jnp.float32) * scale
        p = jax.nn.softmax(jnp.concatenate([s_lat, s_ctx], axis=-1), axis=-1).astype(v.dtype)
        o = (jnp.einsum('bhnqk,bhnkd->bhnqd', p[..., :nk], v_b)
             + jnp.einsum('bhnqc,bhcd->bhnqd', p[..., nk:], v_c))
        return o.reshape(bsz, NA_HEADS, GRID_W, NA_HEAD_DIM)

    o = lax.map(row_block, jnp.arange(rows))
    return jnp.transpose(o, (1, 0, 3, 2, 4)).reshape(bsz, n, D_MODEL) @ w_o


def setup_inputs(seed: int = 0) -> dict:
    key = jax.random.key(seed)
    ks = jax.random.split(key, 19)
    D = D_MODEL
    G = POOL_GROUP_DIM

    def nrm(k, shape, s):
        return jax.random.normal(k, shape, jnp.float32) * s

    return {
        'x': nrm(ks[0], (BATCH, SEQ, D), 1.0),
        'c': nrm(ks[1], (BATCH, D), 1.0),
        'ctx': nrm(ks[2], (BATCH, CTX_LEN, D), 1.0),
        'c_ctx': nrm(ks[3], (D,), 1.0),
        'ada_w': nrm(ks[4], (DEPTH, D, ADA_CHUNKS * D), 0.5 * D ** -0.5),
        'ada_b': nrm(ks[5], (DEPTH, ADA_CHUNKS * D), 0.02),
        'mix_pre_g': 1.0 + nrm(ks[6], (DEPTH, D), 0.05),
        'mix_post_g': 1.0 + nrm(ks[7], (DEPTH, D), 0.05),
        'ffn_pre_g': 1.0 + nrm(ks[8], (DEPTH, D), 0.05),
        'ffn_post_g': 1.0 + nrm(ks[9], (DEPTH, D), 0.05),
        'pool_w': nrm(ks[10], (N_A_LAYERS, POOL_GROUPS, G, G), G ** -0.5),
        'pool_scale': 1.0 + nrm(ks[11], (N_A_LAYERS, D), 0.1),
        'na_w_qkv': nrm(ks[12], (N_B_LAYERS, D, 3 * D), D ** -0.5),
        'na_w_o': nrm(ks[13], (N_B_LAYERS, D, D), D ** -0.5),
        'na_rpb': nrm(ks[14], (N_B_LAYERS, NA_HEADS, 2 * WIN_H - 1, 2 * WIN_W - 1), 0.5),
        'ffn_w_up': nrm(ks[15], (DEPTH, D, 2 * D_FF), D ** -0.5),
        'ffn_conv_w': nrm(ks[16], (DEPTH, CONV_W, 2 * D_FF), CONV_W ** -0.5),
        'ffn_conv_b': nrm(ks[17], (DEPTH, 2 * D_FF), 0.02),
        'ffn_w_down': nrm(ks[18], (DEPTH, D_FF, D), D_FF ** -0.5),
    }


def reference(x, c, ctx, c_ctx, ada_w, ada_b, mix_pre_g, mix_post_g, ffn_pre_g, ffn_post_g,
              pool_w, pool_scale, na_w_qkv, na_w_o, na_rpb,
              ffn_w_up, ffn_conv_w, ffn_conv_b, ffn_w_down):
    for i in range(DEPTH):
        last = i == DEPTH - 1
        j = i // N_MIXERS
        sh1, sc1, g1, sh2, sc2, g2 = ada_mods(c, ada_w[i], ada_b[i])
        csh1, csc1, cg1, csh2, csc2, cg2 = ada_mods(c_ctx, ada_w[i], ada_b[i])

        u = modulate(rms_norm(x, mix_pre_g[i]), sh1, sc1)
        if i % N_MIXERS == 0:
            y = pool_mixer(u, pool_w[j], pool_scale[j])
            if not last:
                uc = modulate(rms_norm(ctx, mix_pre_g[i]), csh1, csc1)
                yc = pool_mixer(uc, pool_w[j], pool_scale[j])
        else:
            uc = modulate(rms_norm(ctx, mix_pre_g[i]), csh1, csc1)
            y = neighbourhood_attention(u, uc, na_w_qkv[j], na_w_o[j], na_rpb[j])
            if not last:
                yc = context_self_attention(uc, na_w_qkv[j], na_w_o[j])
        x = x + g1 * rms_norm(y, mix_post_g[i])
        if not last:
            ctx = ctx + cg1 * rms_norm(yc, mix_post_g[i])

        f = conv_ffn(modulate(rms_norm(x, ffn_pre_g[i]), sh2, sc2),
                     ffn_w_up[i], ffn_conv_w[i], ffn_conv_b[i], ffn_w_down[i])
        x = x + g2 * rms_norm(f, ffn_post_g[i])
        if not last:
            fc = conv_ffn(modulate(rms_norm(ctx, ffn_pre_g[i]), csh2, csc2),
                          ffn_w_up[i], ffn_conv_w[i], ffn_conv_b[i], ffn_w_down[i])
            ctx = ctx + cg2 * rms_norm(fc, ffn_post_g[i])
    return x
```

```cpp
#include <hip/hip_runtime.h>
#include <cstdio>
#include <cstdint>

#ifndef MK_N_LAUNCHES
#define MK_N_LAUNCHES 1
#endif

constexpr int D = 1024, SEQ = 8192, M_X = 16384, CTXL = 256, M_T = 16896;
constexpr int DFF = 2816, NUP = 5632, NHEAD = 16, ADA = 6144;
constexpr float EPS = 1e-6f;
constexpr float LOG2E = 1.4426950408889634f;
constexpr float QSCALE = 0.125f * LOG2E;

constexpr size_t MiB = 1u << 20;
constexpr size_t WS_CTL = 0, CTL_ZERO_BYTES = 1 * MiB;
constexpr size_t WS_MODS = 1 * MiB;
constexpr size_t WS_RPB = 1 * MiB + 256 * 1024;
constexpr size_t WS_XC = 2 * MiB;
constexpr size_t WS_WPOOL = 4 * MiB;
constexpr size_t WS_WQKV = 5 * MiB;
constexpr size_t WS_WO = 11 * MiB;
constexpr size_t WS_WUP = 13 * MiB;
constexpr size_t WS_WDN = 35 * MiB;
constexpr size_t WS_AD = 46 * MiB;
constexpr size_t WS_Y = 79 * MiB;
constexpr size_t WS_G = 145 * MiB;
constexpr size_t WS_Q = WS_G, WS_K = WS_G + 33 * MiB, WS_V = WS_Y, WS_VT = WS_Y + 33 * MiB;
constexpr size_t WS_END = WS_G + (size_t)M_T * DFF * 2;
static_assert(WS_END <= 256 * MiB, "workspace map");
static_assert(WS_K + 33 * MiB <= WS_END && WS_VT + 33 * MiB <= WS_G, "overlays");

constexpr int CW_TMO = 0, CW_QUEUE = 64, CW_BAR = 4096;

namespace pg8 {
#define PG8_LAS __attribute__((address_space(3)))
typedef unsigned short bf16_t;
typedef short bf16x8 __attribute__((ext_vector_type(8)));
typedef float f32x4 __attribute__((ext_vector_type(4)));
typedef unsigned u32x4 __attribute__((ext_vector_type(4)));
typedef unsigned u32x2 __attribute__((ext_vector_type(2)));
constexpr int BM = 256, BK = 64, HALF = 128, HTB = HALF * BK * 2, STAGE_BYTES = 8 * HTB, NXCD = 8, WGM = 8;

__host__ __device__ __forceinline__ int lds_byte(int r, int c) { const int st = (r >> 4) * 2 + (c >> 5), rr = r & 15, cc = c & 31, ob = rr * 64 + cc * 2; return st * 1024 + (ob ^ (((ob >> 9) & 1) << 5)); }
__host__ __device__ __forceinline__ void stage_rc(int b, int& R, int& C) { const int st = b / 1024, sb = b % 1024, swz = sb ^ (((sb >> 9) & 1) << 5); R = (st >> 1) * 16 + swz / 64; C = (st & 1) * 32 + (swz % 64) / 2; }
__host__ __device__ __forceinline__ int perm32(int rho) { const int n = rho >> 4, i = rho & 15; return 8 * (i >> 2) + 4 * n + (i & 3); }

struct Unit { int arow, pn, flags; };
struct Gemm { const bf16_t* A; const bf16_t* Bt; int lda, ldb, K, a_pn_off; };

struct Sched {
    int G, c, mode;
    int nM1, nN1, nM2, nN2, rt2, pn2;
    __device__ __forceinline__ static void swz(int L, int nM, int nN, int& tm, int& pn) {
        const int nwg = nM * nN; int wgid = L; { const int q = nwg / NXCD, r = nwg % NXCD, xcd = wgid % NXCD, off = wgid / NXCD; wgid = (xcd < r ? xcd * (q + 1) : r * (q + 1) + (xcd - r) * q) + off; }
        const int nig = WGM * nN, gid = wgid / nig, fm = gid * WGM, gsz = (nM - fm) < WGM ? (nM - fm) : WGM;
        tm = fm + ((wgid % nig) % gsz); pn = (wgid % nig) / gsz;
    }
    __device__ __forceinline__ bool next(int i, Unit& u) const {
        const long L = (long)i * G + c; const int n1 = nM1 * nN1, n2 = nM2 * nN2; int tm, pn;
        if (L < n1) {
            swz((int)L, nM1, nN1, tm, pn); u.pn = pn;
            if (mode == 0) { u.arow = 256 * tm; u.flags = 0; }
            else if (tm < 66) { const int sq = tm / 33, k = tm - 33 * sq; const int s = 254 * k < 7936 ? 254 * k : 7936; u.arow = sq * 8192 + s; u.flags = (k == 0 ? 1 : 0) | (k == 32 ? 2 : 0); }
            else { u.arow = 16384 + 256 * (tm - 66); u.flags = 3; }
            return true;
        }
        if (L < n1 + n2) { swz((int)(L - n1), nM2, nN2, tm, pn); u.arow = 256 * (rt2 + tm); u.pn = pn2 + pn; u.flags = 0; return true; }
        return false;
    }
};

__device__ __forceinline__ unsigned cvt_pk_bf16(float lo, float hi) { unsigned r; asm volatile("v_cvt_pk_bf16_f32 %0, %1, %2" : "=v"(r) : "v"(lo), "v"(hi)); return r; }

struct EpiF32 {
    static constexpr bool PERM = false, USES_LDS = false;
    float* C; int ldc;
    __device__ __forceinline__ void operator()(const f32x4 (&acc)[2][2][4][2], const Unit& u, int wr, int wc, int fr, int fq) const {
        const int row0 = u.arow + wr * 64 + fr, col0 = u.pn * BM + wc * 32 + 4 * fq;
#pragma unroll
        for (int ai = 0; ai < 2; ++ai)
#pragma unroll
            for (int m = 0; m < 4; ++m) { float* rowp = C + (size_t)(row0 + ai * HALF + m * 16) * ldc + col0;
#pragma unroll
                for (int bj = 0; bj < 2; ++bj)
#pragma unroll
                    for (int n = 0; n < 2; ++n) *(f32x4*)(rowp + bj * HALF + n * 16) = acc[ai][bj][m][n]; }
    }
};
struct EpiQKV {
    static constexpr bool PERM = true, USES_LDS = false;
    bf16_t* Oq; long dk, dv; float scale0;
    __device__ __forceinline__ void operator()(const f32x4 (&acc)[2][2][4][2], const Unit& u, int wr, int wc, int fr, int fq) const {
        const int t = u.pn >> 2; bf16_t* base = Oq + (t >= 1 ? dk : 0l) + (t >= 2 ? dv : 0l); const float sc = t == 0 ? scale0 : 1.f;
        const int row0 = u.arow + wr * 64 + fr, col0 = (u.pn & 3) * BM + wc * 32 + 8 * fq;
#pragma unroll
        for (int ai = 0; ai < 2; ++ai)
#pragma unroll
            for (int m = 0; m < 4; ++m) { bf16_t* rowp = base + (size_t)(row0 + ai * HALF + m * 16) * 1024 + col0;
#pragma unroll
                for (int bj = 0; bj < 2; ++bj) { const f32x4 v0 = acc[ai][bj][m][0] * sc, v1 = acc[ai][bj][m][1] * sc;
                    u32x4 w; w.x = cvt_pk_bf16(v0[0], v0[1]); w.y = cvt_pk_bf16(v0[2], v0[3]); w.z = cvt_pk_bf16(v1[0], v1[1]); w.w = cvt_pk_bf16(v1[2], v1[3]);
                    *(u32x4*)(rowp + bj * HALF) = w; } }
    }
};
__device__ __forceinline__ float dpp_up(float v) { return __builtin_bit_cast(float, __builtin_amdgcn_update_dpp(0, __builtin_bit_cast(int, v), 0x121, 0xf, 0xf, false)); }
__device__ __forceinline__ float dpp_dn(float v) { return __builtin_bit_cast(float, __builtin_amdgcn_update_dpp(0, __builtin_bit_cast(int, v), 0x12F, 0xf, 0xf, false)); }
__device__ __forceinline__ float gelu_tanh(float v) {
    const float z = v * (1.5957691216f + 0.0713548163f * v * v);
    const float e = __builtin_amdgcn_exp2f(-LOG2E * z);
    return v * __builtin_amdgcn_rcpf(1.0f + e);
}
struct EpiConvAct {
    static constexpr bool PERM = true, USES_LDS = true;
    bf16_t* Gout; const float* cw; const float* cb;
    __device__ __forceinline__ void run(const f32x4 (&acc)[2][2][4][2], const Unit& u, int wr, int wc, int fr, int fq, PG8_LAS unsigned char* ldsx) const {
        PG8_LAS float* E = (PG8_LAS float*)ldsx;
        const int cih = wc * 32 + 8 * fq;
#pragma unroll
        for (int ai = 0; ai < 2; ++ai) { const int blk = 2 * ai + wr;
#pragma unroll
            for (int bj = 0; bj < 2; ++bj)
#pragma unroll
                for (int n = 0; n < 2; ++n) {
                    if (fr == 0)  *(PG8_LAS f32x4*)(E + (blk * 2 + 0) * 256 + bj * 128 + cih + 4 * n) = acc[ai][bj][0][n];
                    if (fr == 15) *(PG8_LAS f32x4*)(E + (blk * 2 + 1) * 256 + bj * 128 + cih + 4 * n) = acc[ai][bj][3][n];
                } }
        asm volatile("s_waitcnt lgkmcnt(0)" ::: "memory"); __builtin_amdgcn_s_barrier(); asm volatile("" ::: "memory");
        const int gcol0 = u.pn * 128 + cih;
        const bool first = (u.flags & 1) != 0, last = (u.flags & 2) != 0;
        u32x2 keep[2][4];
#pragma unroll
        for (int n = 0; n < 2; ++n) {
            const int gc = gcol0 + 4 * n;
            const f32x4 wg0 = *(const f32x4*)(cw + gc), wg1 = *(const f32x4*)(cw + NUP + gc), wg2 = *(const f32x4*)(cw + 2 * NUP + gc), bg = *(const f32x4*)(cb + gc);
            const f32x4 wv0 = *(const f32x4*)(cw + DFF + gc), wv1 = *(const f32x4*)(cw + NUP + DFF + gc), wv2 = *(const f32x4*)(cw + 2 * NUP + DFF + gc), bv = *(const f32x4*)(cb + DFF + gc);
#pragma unroll
            for (int ai = 0; ai < 2; ++ai) { const int blk = 2 * ai + wr;
                f32x4 upg = {0.f, 0.f, 0.f, 0.f}, upv = upg, dng = upg, dnv = upg;
                if (blk > 0) { upg = *(PG8_LAS f32x4*)(E + ((blk - 1) * 2 + 1) * 256 + cih + 4 * n); upv = *(PG8_LAS f32x4*)(E + ((blk - 1) * 2 + 1) * 256 + 128 + cih + 4 * n); }
                if (blk < 3) { dng = *(PG8_LAS f32x4*)(E + ((blk + 1) * 2 + 0) * 256 + cih + 4 * n); dnv = *(PG8_LAS f32x4*)(E + ((blk + 1) * 2 + 0) * 256 + 128 + cih + 4 * n); }
#pragma unroll
                for (int m = 0; m < 4; ++m) {
                    const f32x4 cg = acc[ai][0][m][n], cv = acc[ai][1][m][n];
                    float og[4];
#pragma unroll
                    for (int e = 0; e < 4; ++e) {
                        float ug = dpp_up(cg[e]), uv = dpp_up(cv[e]), dg = dpp_dn(cg[e]), dv = dpp_dn(cv[e]);
                        const float pg = m > 0 ? dpp_up(acc[ai][0][m > 0 ? m - 1 : 0][n][e]) : upg[e], pv = m > 0 ? dpp_up(acc[ai][1][m > 0 ? m - 1 : 0][n][e]) : upv[e];
                        const float ng = m < 3 ? dpp_dn(acc[ai][0][m < 3 ? m + 1 : 3][n][e]) : dng[e], nv = m < 3 ? dpp_dn(acc[ai][1][m < 3 ? m + 1 : 3][n][e]) : dnv[e];
                        if (fr == 0) { ug = pg; uv = pv; }
                        if (fr == 15) { dg = ng; dv = nv; }
                        const float hg = bg[e] + wg0[e] * ug + wg1[e] * cg[e] + wg2[e] * dg;
                        const float hv = bv[e] + wv0[e] * uv + wv1[e] * cv[e] + wv2[e] * dv;
                        og[e] = gelu_tanh(hg) * hv;
                    }
                    u32x2 w; w.x = cvt_pk_bf16(og[0], og[1]); w.y = cvt_pk_bf16(og[2], og[3]);
                    if (n == 0) keep[ai][m] = w;
                    else {
                        const int tr = 128 * ai + 64 * wr + 16 * m + fr;
                        const bool ok = (tr >= 1 && tr <= 254) || (tr == 0 && first) || (tr == 255 && last);
                        if (ok) { u32x4 o; o.x = keep[ai][m].x; o.y = keep[ai][m].y; o.z = w.x; o.w = w.y; *(u32x4*)(Gout + (size_t)(u.arow + tr) * DFF + gcol0) = o; }
                    }
                }
            }
        }
    }
};

template <class Epi, bool ALIGN_EPI = true>
__device__ __forceinline__ void gemm_phase(PG8_LAS unsigned char* lds, const Gemm g, const Sched& S, const Epi& E) {
    const int tid = threadIdx.x, wid = __builtin_amdgcn_readfirstlane(tid >> 6), lane = tid & 63, wr = wid >> 2, wc = wid & 3, fr = lane & 15, fq = lane >> 4;
    const int K = g.K, nt = K / BK;
    unsigned voffA[2], voffB[2];
#pragma unroll
    for (int i = 0; i < 2; ++i) { int R, C; stage_rc(tid * 16 + i * 8192, R, C); const int Rb = Epi::PERM ? ((R & ~31) + perm32(R & 31)) : R;
        voffA[i] = (unsigned)(R * g.lda + C) * 2u; voffB[i] = (unsigned)(Rb * g.ldb + C) * 2u; }
    const size_t kstep = (size_t)(BK * 2);
    const size_t hstepA = (size_t)HALF * g.lda * 2, hstepB = (size_t)HALF * g.ldb * 2;
    const unsigned ldsw = (unsigned)wid * 1024u;
    const int aoff = lds_byte(wr * 64 + fr, fq * 8), boff = lds_byte(wc * 32 + fr, fq * 8);
#define PG8_SA(b, h) (((b) * 2 + (h)) * HTB)
#define PG8_SB(b, h) ((4 + (b) * 2 + (h)) * HTB)
#define PG8_STAGE(bufoff, gbase, voff) do { _Pragma("unroll") for (int _i = 0; _i < 2; ++_i) \
        __builtin_amdgcn_global_load_lds((const unsigned*)((const char*)(gbase) + (voff)[_i]), (PG8_LAS unsigned*)(lds + (bufoff) + ldsw + _i * 8192), 16, 0, 0); } while (0)
#define PG8_LDA(dst, b, h) do { _Pragma("unroll") for (int m = 0; m < 4; ++m) _Pragma("unroll") for (int k = 0; k < 2; ++k) dst[m][k] = *(const PG8_LAS bf16x8*)(lds + PG8_SA(b, h) + aoff + m * 2048 + k * 1024); } while (0)
#define PG8_LDB(dst, b, h) do { _Pragma("unroll") for (int n = 0; n < 2; ++n) _Pragma("unroll") for (int k = 0; k < 2; ++k) dst[n][k] = *(const PG8_LAS bf16x8*)(lds + PG8_SB(b, h) + boff + n * 2048 + k * 1024); } while (0)
#define PG8_MMA(ai, bj, At, Bt) do { __builtin_amdgcn_s_setprio(1); _Pragma("unroll") for (int m = 0; m < 4; ++m) _Pragma("unroll") for (int n = 0; n < 2; ++n) _Pragma("unroll") for (int k = 0; k < 2; ++k) \
        acc[ai][bj][m][n] = __builtin_amdgcn_mfma_f32_16x16x32_bf16(Bt[n][k], At[m][k], acc[ai][bj][m][n], 0, 0, 0); __builtin_amdgcn_s_setprio(0); } while (0)
#define PG8_WAIT_V(n) asm volatile("s_waitcnt vmcnt(" #n ")" ::: "memory")
#define PG8_WAIT_L(n) asm volatile("s_waitcnt lgkmcnt(" #n ")" ::: "memory")
#define PG8_BAR __builtin_amdgcn_s_barrier()
#define PG8_SCHED __builtin_amdgcn_sched_barrier(0)
    Unit cur, nxt; int ui = 0;
    if (!S.next(0, cur)) return;
    f32x4 acc[2][2][4][2];
#pragma unroll
    for (int a = 0; a < 2; ++a)
#pragma unroll
        for (int b = 0; b < 2; ++b)
#pragma unroll
            for (int m = 0; m < 4; ++m)
#pragma unroll
                for (int n = 0; n < 2; ++n) acc[a][b][m][n] = (f32x4){0.f, 0.f, 0.f, 0.f};
    bf16x8 At[4][2], B0[2][2], B1[2][2];
    const char* cA = (const char*)g.A + ((size_t)cur.arow * g.lda + (size_t)cur.pn * g.a_pn_off) * 2; const char* cB = (const char*)g.Bt + (size_t)cur.pn * BM * g.ldb * 2;
    PG8_STAGE(PG8_SB(0, 0), cB, voffB); PG8_STAGE(PG8_SB(0, 1), cB + hstepB, voffB); PG8_STAGE(PG8_SA(0, 0), cA, voffA); PG8_STAGE(PG8_SA(0, 1), cA + hstepA, voffA);
    if (wr == 1) PG8_BAR;
    PG8_WAIT_V(2); PG8_BAR;
    PG8_STAGE(PG8_SB(1, 0), cB + kstep, voffB); PG8_STAGE(PG8_SA(1, 0), cA + kstep, voffA); PG8_STAGE(PG8_SB(1, 1), cB + hstepB + kstep, voffB);
    PG8_WAIT_V(6); PG8_BAR;
    for (;;) {
        const bool has_next = S.next(ui + 1, nxt);
        const char* nA = has_next ? (const char*)g.A + ((size_t)nxt.arow * g.lda + (size_t)nxt.pn * g.a_pn_off) * 2 : cA; const char* nB = has_next ? (const char*)g.Bt + (size_t)nxt.pn * BM * g.ldb * 2 : cB;
        for (int t = 0; t < nt; t += 2) {
            const bool last = (t == nt - 2);
            const char* a1 = cA + (size_t)(t + 1) * kstep;
            const char* a2 = last ? nA : cA + (size_t)(t + 2) * kstep; const char* b2 = last ? nB : cB + (size_t)(t + 2) * kstep;
            const char* a3 = a2 + kstep; const char* b3 = b2 + kstep;
            PG8_LDB(B0, 0, 0); PG8_LDB(B1, 0, 1); PG8_SCHED; PG8_LDA(At, 0, 0); PG8_STAGE(PG8_SA(1, 1), a1 + hstepA, voffA);
            PG8_WAIT_V(8); PG8_WAIT_L(0); PG8_BAR; PG8_MMA(0, 0, At, B0); PG8_MMA(0, 1, At, B1); PG8_BAR; PG8_SCHED;
            PG8_LDA(At, 0, 1); PG8_STAGE(PG8_SB(0, 0), b2, voffB); PG8_STAGE(PG8_SB(0, 1), b2 + hstepB, voffB); PG8_STAGE(PG8_SA(0, 0), a2, voffA);
            PG8_WAIT_V(8); PG8_WAIT_L(0); PG8_BAR; PG8_MMA(1, 0, At, B0); PG8_MMA(1, 1, At, B1); PG8_BAR; PG8_SCHED;
            PG8_LDB(B0, 1, 0); PG8_LDB(B1, 1, 1); PG8_SCHED; PG8_LDA(At, 1, 0); PG8_STAGE(PG8_SA(0, 1), a2 + hstepA, voffA);
            PG8_WAIT_V(8); PG8_WAIT_L(0); PG8_BAR; PG8_MMA(0, 0, At, B0); PG8_MMA(0, 1, At, B1); PG8_BAR; PG8_SCHED;
            PG8_LDA(At, 1, 1); PG8_STAGE(PG8_SB(1, 0), b3, voffB); PG8_STAGE(PG8_SB(1, 1), b3 + hstepB, voffB); PG8_STAGE(PG8_SA(1, 0), a3, voffA);
            PG8_WAIT_V(8); PG8_WAIT_L(0); PG8_BAR; PG8_MMA(1, 0, At, B0); PG8_MMA(1, 1, At, B1); PG8_BAR; PG8_SCHED;
        }
        if constexpr (ALIGN_EPI) { if (wr == 0) PG8_BAR; }
        if constexpr (Epi::USES_LDS) E.run(acc, cur, wr, wc, fr, fq, lds + STAGE_BYTES); else E(acc, cur, wr, wc, fr, fq);
        if (!has_next) break;
#pragma unroll
        for (int a = 0; a < 2; ++a)
#pragma unroll
            for (int b = 0; b < 2; ++b)
#pragma unroll
                for (int m = 0; m < 4; ++m)
#pragma unroll
                    for (int n = 0; n < 2; ++n) acc[a][b][m][n] = (f32x4){0.f, 0.f, 0.f, 0.f};
        cur = nxt; cA = nA; cB = nB; ++ui;
        if constexpr (ALIGN_EPI) { if (wr == 1) PG8_BAR; }
    }
    PG8_WAIT_V(0);
    if constexpr (!ALIGN_EPI) { if (wr == 0) PG8_BAR; }
    PG8_BAR;
#undef PG8_SA
#undef PG8_SB
#undef PG8_STAGE
#undef PG8_LDA
#undef PG8_LDB
#undef PG8_MMA
#undef PG8_WAIT_V
#undef PG8_WAIT_L
#undef PG8_BAR
#undef PG8_SCHED
}
}

constexpr int RING_OFF = 0, RING_BYTES = 131072;
constexpr int EDGE_OFF = RING_BYTES, EDGE_BYTES = 8192;
constexpr int LDSCTL_OFF = EDGE_OFF + EDGE_BYTES, MISC_OFF = LDSCTL_OFF + 320;
constexpr int LDS_BYTES = 147456;
static_assert(MISC_OFF + 128 <= LDS_BYTES, "LDS map");
constexpr int NWAVES = 8;

#define GAS __attribute__((address_space(1)))
#define LAS __attribute__((address_space(3)))
typedef unsigned short bf16;
typedef unsigned v4u __attribute__((ext_vector_type(4)));
typedef unsigned v2u __attribute__((ext_vector_type(2)));
typedef float f32x4 __attribute__((ext_vector_type(4)));
typedef short bf16x8 __attribute__((ext_vector_type(8)));
typedef GAS unsigned gu32;
#define RLX_AGENT __ATOMIC_RELAXED, __HIP_MEMORY_SCOPE_AGENT
#define LDS_WAIT() asm volatile("s_waitcnt lgkmcnt(0)" ::: "memory")
#define VM_WAIT() asm volatile("s_waitcnt vmcnt(0)" ::: "memory")
__device__ __forceinline__ unsigned f2bf(float f) { unsigned u = __builtin_bit_cast(unsigned, f); return (u + 0x7fffu + ((u >> 16) & 1u)) >> 16; }
__device__ __forceinline__ unsigned pk2(float lo, float hi) { return f2bf(lo) | (f2bf(hi) << 16); }

#define XB_TMO      128
#define XB_XCNT(j)  (256  + 64 * (j))
#define XB_XSUB(j)  (1280 + 64 * (j))
#define XB_XGEN(j)  (2304 + 64 * (j))
#define XB_TOP      3328
#define XB_TOPGEN   3392
#define XCD_BAR_WORDS 3456
#define XB_SPIN_CAP (1u << 18)
__device__ __forceinline__ unsigned xb_ld(unsigned* p)              { return __hip_atomic_load(p, __ATOMIC_RELAXED, __HIP_MEMORY_SCOPE_AGENT); }
__device__ __forceinline__ unsigned xb_add(unsigned* p, unsigned v) { return __hip_atomic_fetch_add(p, v, __ATOMIC_RELAXED, __HIP_MEMORY_SCOPE_AGENT); }
__device__ __forceinline__ unsigned xb_xcc_id() { return (unsigned)__builtin_amdgcn_s_getreg((3 << 11) | 20) & 0xFu; }
#define XB_SPIN(cond, bar) do { unsigned _sp = 0; while (cond) { __builtin_amdgcn_s_sleep(1); \
    if ((++_sp & 255u) == 0u) { if (xb_ld(&(bar)[XB_TMO])) break; if (_sp > XB_SPIN_CAP) { atomicAdd(&(bar)[XB_TMO], 1u); break; } } } } while (0)
struct XcdBarrier { unsigned* bar; unsigned x; volatile LAS unsigned* st; };
__device__ __forceinline__ XcdBarrier xcd_barrier_post(unsigned* bar, volatile LAS unsigned* st) {
    XcdBarrier b; b.bar = bar; b.x = xb_xcc_id(); b.st = st;
    if (threadIdx.x == 0) (void)xb_add(&bar[XB_XCNT(b.x)], 1u);
    return b;
}
__device__ __forceinline__ void xcd_barrier_complete(unsigned* bar, unsigned x, unsigned& nloc, unsigned& nx) {
    const unsigned G = gridDim.x * gridDim.y * gridDim.z;
    unsigned sum, cnt, mine, sp = 0u;
    for (;;) {
        sum = 0u; cnt = 0u; mine = 0u;
#pragma unroll
        for (unsigned j = 0; j < 16; ++j) { const unsigned c = xb_ld(&bar[XB_XCNT(j)]); sum += c; cnt += (c > 0u) ? 1u : 0u; mine = (j == x) ? c : mine; }
        if (sum == G) break;
        __builtin_amdgcn_s_sleep(1);
        if ((++sp & 255u) == 0u) { if (xb_ld(&bar[XB_TMO])) break; if (sp > XB_SPIN_CAP) { atomicAdd(&bar[XB_TMO], 1u); break; } }
    }
    nloc = mine > 0u ? mine : 1u; nx = cnt > 0u ? cnt : 1u;
}
__device__ __forceinline__ void xcd_barrier(const XcdBarrier& b) {
    asm volatile("s_waitcnt vmcnt(0)" ::: "memory");
    __syncthreads();
    if (threadIdx.x == 0) {
        unsigned* bar = b.bar;
        __builtin_amdgcn_s_waitcnt(0);
        unsigned nloc = b.st[0], nx = b.st[1];
        if (nloc == 0u) { xcd_barrier_complete(bar, b.x, nloc, nx); b.st[0] = nloc; b.st[1] = nx; }
        const unsigned old = xb_add(&bar[XB_XSUB(b.x)], 1u);
        const unsigned gen = old / nloc;
        if (old + 1u == (gen + 1u) * nloc) {
            __builtin_amdgcn_fence(__ATOMIC_RELEASE, "agent");
            asm volatile("s_waitcnt vmcnt(0)" ::: "memory");
            const unsigned og = xb_add(&bar[XB_TOP], 1u);
            const unsigned tg = og / nx;
            if (og + 1u == (tg + 1u) * nx) xb_add(&bar[XB_TOPGEN], 1u);
            else XB_SPIN(xb_ld(&bar[XB_TOPGEN]) == tg, bar);
            __builtin_amdgcn_fence(__ATOMIC_ACQUIRE, "agent");
            xb_add(&bar[XB_XGEN(b.x)], 1u);
            asm volatile("s_waitcnt vmcnt(0)" ::: "memory");
        } else {
            XB_SPIN(xb_ld(&bar[XB_XGEN(b.x)]) == gen, bar);
            __builtin_amdgcn_fence(__ATOMIC_ACQUIRE, "agent");
            asm volatile("s_waitcnt vmcnt(0)" ::: "memory");
        }
    }
    __syncthreads();
}

struct Args { const float* in[19]; float* out; unsigned char* ws; int ph_lo, ph_hi; };
struct Frame {
    LAS unsigned char* lds;
    gu32* ctl;
    int tid, lane, wave, vcu, G;
    float* out; unsigned char* ws;
};
typedef __attribute__((address_space(4))) const char* kernarg_cptr;
__device__ __forceinline__ const float* in_ptr(int i) { kernarg_cptr kp = (kernarg_cptr)__builtin_amdgcn_kernarg_segment_ptr(); asm volatile("" : "+s"(kp)); return *(const float* __attribute__((address_space(4))) const*)(kp + 8 * i); }
enum { I_X = 0, I_C, I_CTX, I_CCTX, I_ADAW, I_ADAB, I_MIXPRE, I_MIXPOST, I_FFNPRE, I_FFNPOST, I_POOLW, I_POOLS, I_WQKV, I_WO, I_RPB, I_WUP, I_CONVW, I_CONVB, I_WDOWN };
__device__ __forceinline__ float wave_sum(float v) {
#pragma unroll
    for (int o = 1; o < 64; o <<= 1) v += __shfl_xor(v, o);
    return v;
}
__device__ __forceinline__ float silu(float v) { return v / (1.0f + __expf(-v)); }

__device__ __forceinline__ void p0_transpose_item(const float* W, int ldw, int k0, int n0, bf16* WT, int ldwt, int dst_row0, LAS float* scr, int lane) {
#pragma unroll 8
    for (int i = 0; i < 32; ++i) { const int kk = 2 * i + (lane >> 5); scr[kk * 33 + (lane & 31)] = W[(size_t)(k0 + kk) * ldw + n0 + (lane & 31)]; }
    LDS_WAIT(); asm volatile("" ::: "memory");
    const int c = lane & 7;
#pragma unroll
    for (int j = 0; j < 4; ++j) { const int n = (lane >> 3) + 8 * j; const LAS float* s = scr + (8 * c) * 33 + n;
        v4u o; o.x = pk2(s[0 * 33], s[1 * 33]); o.y = pk2(s[2 * 33], s[3 * 33]); o.z = pk2(s[4 * 33], s[5 * 33]); o.w = pk2(s[6 * 33], s[7 * 33]);
        *(GAS v4u*)(WT + (size_t)(dst_row0 + n) * ldwt + k0 + 8 * c) = o; }
    LDS_WAIT(); asm volatile("" ::: "memory");
}
__device__ __forceinline__ void p0_convert_item(Frame& F, int it, LAS float* scr) {
    if (it < 128) { const int g = it >> 5, r = it & 31, kb = r >> 3, nb = r & 7;
        p0_transpose_item(in_ptr(I_POOLW) + (size_t)g * 65536, 256, 64 * kb, 32 * nb, (bf16*)(F.ws + WS_WPOOL), 256, g * 256 + 32 * nb, scr, F.lane); return; }
    it -= 128;
    if (it < 1536) { const int kb = it / 96, nb = it % 96; p0_transpose_item(in_ptr(I_WQKV), 3072, 64 * kb, 32 * nb, (bf16*)(F.ws + WS_WQKV), 1024, 32 * nb, scr, F.lane); return; }
    it -= 1536;
    if (it < 512) { const int kb = it / 32, nb = it % 32; p0_transpose_item(in_ptr(I_WO), 1024, 64 * kb, 32 * nb, (bf16*)(F.ws + WS_WO), 1024, 32 * nb, scr, F.lane); return; }
    it -= 512;
    if (it < 5632) { const int l = it / 2816, r = it % 2816, kb = r / 176, nb = r % 176; const int n0 = 32 * nb;
        const int half = n0 >= DFF ? 1 : 0, nn = n0 - half * DFF; const int drow = 256 * (nn >> 7) + 128 * half + (nn & 127);
        p0_transpose_item(in_ptr(I_WUP) + (size_t)l * D * NUP, NUP, 64 * kb, n0, (bf16*)(F.ws + WS_WUP) + (size_t)l * NUP * D, 1024, drow, scr, F.lane); return; }
    it -= 5632;
    { const int l = it / 1408, r = it % 1408, kb = r / 32, nb = r % 32;
      p0_transpose_item(in_ptr(I_WDOWN) + (size_t)l * DFF * D, D, 64 * kb, 32 * nb, (bf16*)(F.ws + WS_WDN) + (size_t)l * D * DFF, DFF, 32 * nb, scr, F.lane); }
}
constexpr int N_CONV_ITEMS = 128 + 1536 + 512 + 5632 + 2816;
__device__ __forceinline__ void p0_prologue(Frame& F) {
    const int bid = blockIdx.x;
    float* mods = (float*)(F.ws + WS_MODS);
    if (bid < 192) {
        const float* pc = in_ptr(I_C); const float* pcc = in_ptr(I_CCTX); const float* padaw = in_ptr(I_ADAW); const float* padab = in_ptr(I_ADAB);
        const int l = bid / 96, ch = bid % 96, col = 64 * ch + F.lane, kb = 128 * F.wave;
        float cv[3][2];
#pragma unroll
        for (int h = 0; h < 2; ++h) { cv[0][h] = silu(pc[kb + 64 * h + F.lane]); cv[1][h] = silu(pc[D + kb + 64 * h + F.lane]); cv[2][h] = silu(pcc[kb + 64 * h + F.lane]); }
        const float* W = padaw + (size_t)l * D * ADA + (size_t)kb * ADA + col;
        float a0 = 0.f, a1 = 0.f, a2 = 0.f;
#pragma unroll
        for (int h = 0; h < 2; ++h)
#pragma unroll 16
            for (int kk = 0; kk < 64; ++kk) {
                const float w = W[(size_t)(64 * h + kk) * ADA];
                a0 += __builtin_bit_cast(float, __builtin_amdgcn_readlane(__builtin_bit_cast(int, cv[0][h]), kk)) * w;
                a1 += __builtin_bit_cast(float, __builtin_amdgcn_readlane(__builtin_bit_cast(int, cv[1][h]), kk)) * w;
                a2 += __builtin_bit_cast(float, __builtin_amdgcn_readlane(__builtin_bit_cast(int, cv[2][h]), kk)) * w;
            }
        LAS float* red = (LAS float*)(F.lds + RING_OFF);
        red[(F.wave * 3 + 0) * 64 + F.lane] = a0; red[(F.wave * 3 + 1) * 64 + F.lane] = a1; red[(F.wave * 3 + 2) * 64 + F.lane] = a2;
        __syncthreads();
        if (F.tid < 192) { const int s = F.tid >> 6, ln = F.tid & 63; float v = padab[l * ADA + 64 * ch + ln];
#pragma unroll
            for (int w = 0; w < 8; ++w) v += red[(w * 3 + s) * 64 + ln];
            mods[(size_t)(l * 3 + s) * ADA + 64 * ch + ln] = v; }
        __syncthreads();
    } else if (bid == 255) {
        float* T = (float*)(F.ws + WS_RPB); const float* prpb = in_ptr(I_RPB);
        for (int i = F.tid; i < 16 * 15 * 64; i += NWAVES * 64) { const int j = i & 63, hd = i >> 6; const int dc = j - 16; T[i] = (dc >= 0 && dc < 31) ? LOG2E * prpb[hd * 31 + dc] : 0.f; }
    }
    LAS float* scr = (LAS float*)(F.lds + RING_OFF + 8192 + F.wave * 12288);
    for (;;) {
        int it = 0;
        if (F.lane == 0) it = (int)__hip_atomic_fetch_add(F.ctl + CW_QUEUE, 1u, RLX_AGENT);
        it = __builtin_amdgcn_readfirstlane(it);
        if (it >= N_CONV_ITEMS) break;
        p0_convert_item(F, it, scr);
    }
}

__device__ __forceinline__ const float* rowp_in(const float* xm, const float* xc, int m) { return m < M_X ? xm + (size_t)m * D : xc + (size_t)(m - M_X) * D; }
__device__ __forceinline__ float* rowp_out(float* xm, float* xc, int m) { return m < M_X ? xm + (size_t)m * D : xc + (size_t)(m - M_X) * D; }

__device__ __forceinline__ void p1_pool_operand(Frame& F) {
    LAS float* NR = (LAS float*)(F.lds + RING_OFF);
    const float* mods = (const float*)(F.ws + WS_MODS);
    bf16* AD = (bf16*)(F.ws + WS_AD);
    const float* px = in_ptr(I_X); const float* pctx = in_ptr(I_CTX); const float* ppre = in_ptr(I_MIXPRE);
    for (int ch = F.vcu; ch < M_T / 16; ch += F.G) {
        const int row0 = 16 * ch;
        const int sq0 = row0 < M_X ? (row0 & ~8191) : (row0 & ~255), sq1 = sq0 + (row0 < M_X ? 8192 : 256);
        const int s = row0 < M_X ? (row0 >> 13) : 2;
        for (int j = F.wave; j < 31; j += NWAVES) {
            const int gr = row0 - 8 + j;
            if (gr >= sq0 && gr < sq1) {
                const f32x4* xr = (const f32x4*)rowp_in(px, pctx, gr) + F.lane;
                f32x4 v[4]; float ss = 0.f;
#pragma unroll
                for (int i = 0; i < 4; ++i) { v[i] = xr[64 * i]; ss += (v[i].x * v[i].x + v[i].y * v[i].y) + (v[i].z * v[i].z + v[i].w * v[i].w); }
                const float rstd = 1.0f / sqrtf(wave_sum(ss) * (1.0f / D) + EPS);
#pragma unroll
                for (int i = 0; i < 4; ++i) *(LAS f32x4*)(NR + j * 1024 + 256 * i + 4 * F.lane) = v[i] * rstd;
            }
        }
        __syncthreads();
        f32x4 gm[4];
#pragma unroll
        for (int i = 0; i < 4; ++i) { const int col = 256 * i + 4 * F.lane; const f32x4 g = *(const f32x4*)(ppre + col), sc = *(const f32x4*)(mods + (size_t)(0 * 3 + s) * ADA + 1 * D + col); gm[i] = g * (sc + 1.0f); }
#pragma unroll
        for (int rr = 0; rr < 2; ++rr) {
            const int t = row0 + F.wave + 8 * rr;
#pragma unroll
            for (int i = 0; i < 4; ++i) {
                const int half = 1 << i; const int lo = (t - half) > sq0 ? (t - half) : sq0, hi = (t + half) < sq1 ? (t + half) : sq1;
                f32x4 S = {0.f, 0.f, 0.f, 0.f};
                for (int r = lo; r < hi; ++r) S += *(LAS f32x4*)(NR + (r - row0 + 8) * 1024 + 256 * i + 4 * F.lane);
                const f32x4 cen = *(LAS f32x4*)(NR + (t - row0 + 8) * 1024 + 256 * i + 4 * F.lane);
                const f32x4 dd = (S * (1.0f / (float)(hi - lo)) - cen) * gm[i];
                v2u o; o.x = pk2(dd.x, dd.y); o.y = pk2(dd.z, dd.w);
                *(v2u*)(AD + (size_t)t * D + 256 * i + 4 * F.lane) = o;
            }
        }
        __syncthreads();
    }
}

struct RowPass {
    const float* Y; const float* colscale; const float* post_g; const float* mods_l; int gate_chunk;
    const float* xin_m; const float* xin_c; float* xout_m; float* xout_c;
    bf16* AD; const float* pre_g; const float* mods_n; int sh_chunk, sc_chunk;
    int nrows;
};
__device__ __forceinline__ void row_pass(Frame& F, const RowPass& P) {
    const int gw = F.vcu * NWAVES + F.wave, NGW = F.G * NWAVES;
    const int rpw = (P.nrows + NGW - 1) / NGW;
    const int m0 = gw * rpw, m1 = (m0 + rpw) < P.nrows ? (m0 + rpw) : P.nrows;
    for (int m = m0; m < m1; ++m) {
        const int s = m < M_X ? (m >> 13) : 2;
        const f32x4* yr = (const f32x4*)(P.Y + (size_t)m * D) + F.lane;
        const f32x4* xr = (const f32x4*)rowp_in(P.xin_m, P.xin_c, m) + F.lane;
        f32x4 y[4], xv[4]; float ss = 0.f;
#pragma unroll
        for (int i = 0; i < 4; ++i) { y[i] = yr[64 * i]; xv[i] = xr[64 * i];
            if (P.colscale) y[i] = y[i] * *((const f32x4*)P.colscale + F.lane + 64 * i);
            ss += (y[i].x * y[i].x + y[i].y * y[i].y) + (y[i].z * y[i].z + y[i].w * y[i].w); }
        const float rstd = 1.0f / sqrtf(wave_sum(ss) * (1.0f / D) + EPS);
        float s2 = 0.f;
        f32x4* xo = (f32x4*)rowp_out(P.xout_m, P.xout_c, m) + F.lane;
#pragma unroll
        for (int i = 0; i < 4; ++i) {
            const f32x4 pg = *((const f32x4*)P.post_g + F.lane + 64 * i), gt = *((const f32x4*)(P.mods_l + (size_t)s * ADA + P.gate_chunk * D) + F.lane + 64 * i);
            xv[i] = xv[i] + gt * (y[i] * rstd * pg);
            xo[64 * i] = xv[i];
            s2 += (xv[i].x * xv[i].x + xv[i].y * xv[i].y) + (xv[i].z * xv[i].z + xv[i].w * xv[i].w);
        }
        if (P.AD) {
            const float rs2 = 1.0f / sqrtf(wave_sum(s2) * (1.0f / D) + EPS);
#pragma unroll
            for (int i = 0; i < 4; ++i) {
                const f32x4 g = *((const f32x4*)P.pre_g + F.lane + 64 * i), sc = *((const f32x4*)(P.mods_n + (size_t)s * ADA + P.sc_chunk * D) + F.lane + 64 * i), sh = *((const f32x4*)(P.mods_n + (size_t)s * ADA + P.sh_chunk * D) + F.lane + 64 * i);
                const f32x4 a = (xv[i] * rs2 * g) * (sc + 1.0f) + sh;
                v2u o; o.x = pk2(a.x, a.y); o.y = pk2(a.z, a.w);
                *(v2u*)(P.AD + (size_t)m * D + 256 * i + 4 * F.lane) = o;
            }
        }
    }
}

__device__ __forceinline__ void p8_vtranspose(Frame& F) {
    const bf16* V = (const bf16*)(F.ws + WS_V); bf16* VT = (bf16*)(F.ws + WS_VT); bf16* VCT = VT + (size_t)2 * 16 * 64 * 8192;
    LAS unsigned char* scr = F.lds + RING_OFF + F.wave * 16384;
    const int gw = F.vcu * NWAVES + F.wave, NGW = F.G * NWAVES;
    for (int it = gw; it < 4096 + 128; it += NGW) {
        int b, h, tb, seqlen, rowbase; bf16* dst;
        if (it < 4096) { b = it >> 11; h = (it >> 7) & 15; tb = it & 127; seqlen = 8192; rowbase = b * 8192; dst = VT + (size_t)(b * 16 + h) * 64 * 8192; }
        else { const int j = it - 4096; b = j >> 6; h = (j >> 2) & 15; tb = j & 3; seqlen = 256; rowbase = M_X + b * 256; dst = VCT + (size_t)(b * 16 + h) * 64 * 256; }
#pragma unroll
        for (int i = 0; i < 8; ++i) { const int row = 8 * i + (F.lane >> 3), chn = F.lane & 7;
            const v4u v = *(const v4u*)(V + (size_t)(rowbase + 64 * tb + row) * D + h * 64 + 8 * chn);
            *(LAS v4u*)(scr + row * 144 + chn * 16) = v; }
        LDS_WAIT(); asm volatile("" ::: "memory");
        const int tp = F.lane & 31, dd = F.lane >> 5;
#pragma unroll 8
        for (int i = 0; i < 32; ++i) { const int d = 2 * i + dd;
            const unsigned lo = *(LAS unsigned short*)(scr + (2 * tp) * 144 + 2 * d), hi = *(LAS unsigned short*)(scr + (2 * tp + 1) * 144 + 2 * d);
            *(unsigned*)(dst + (size_t)d * seqlen + 64 * tb + 2 * tp) = lo | (hi << 16); }
        LDS_WAIT(); asm volatile("" ::: "memory");
    }
}

__device__ __forceinline__ void p9_attention(Frame& F) {
    const bf16* Q = (const bf16*)(F.ws + WS_Q); const bf16* Kb = (const bf16*)(F.ws + WS_K);
    const bf16* VT = (const bf16*)(F.ws + WS_VT); const bf16* VCT = VT + (size_t)2 * 16 * 64 * 8192;
    bf16* O = (bf16*)(F.ws + WS_Q);
    const float* RT = (const float*)(F.ws + WS_RPB);
    const int l15 = F.lane & 15, g = F.lane >> 4;
    for (int itw = F.vcu; itw < 2048; itw += F.G) {
        const int item = itw * 8 + F.wave;
        const int cb = item & 3, r = (item >> 2) & 127, h = (item >> 9) & 15, b = item >> 13;
        const int s0 = (r - 4) < 0 ? 0 : ((r - 4) > 120 ? 120 : (r - 4));
        const int bs = cb == 0 ? 0 : (cb == 1 ? 8 : (cb == 2 ? 24 : 32));
        const int qc = 16 * cb + l15;
        const size_t tq = (size_t)b * 8192 + r * 64 + qc;
        bf16x8 qf[2];
#pragma unroll
        for (int ks = 0; ks < 2; ++ks) qf[ks] = *(const bf16x8*)(Q + tq * D + h * 64 + 32 * ks + 8 * g);
        const int kap = 8 * (l15 >> 2) + (l15 & 3);
        f32x4 sc[16][2];
#pragma unroll
        for (int p = 0; p < 16; ++p) {
            const size_t kt0 = p < 8 ? ((size_t)b * 8192 + (size_t)(s0 + p) * 64 + bs) : ((size_t)M_X + b * 256 + 32 * (p - 8));
#pragma unroll
            for (int tau = 0; tau < 2; ++tau) {
                const bf16* kp = Kb + (kt0 + kap + 4 * tau) * D + h * 64 + 8 * g;
                const bf16x8 k0 = *(const bf16x8*)kp, k1 = *(const bf16x8*)(kp + 32);
                f32x4 a = {0.f, 0.f, 0.f, 0.f};
                a = __builtin_amdgcn_mfma_f32_16x16x32_bf16(k0, qf[0], a, 0, 0, 0);
                a = __builtin_amdgcn_mfma_f32_16x16x32_bf16(k1, qf[1], a, 0, 0, 0);
                sc[p][tau] = a;
            }
        }
        const int wst = (qc - 8) < 0 ? 0 : ((qc - 8) > 48 ? 48 : (qc - 8));
        float mx = -3.0e38f;
#pragma unroll
        for (int p = 0; p < 8; ++p) {
            const int dr = s0 + p - r + 7;
            const float* rt = RT + (size_t)(h * 15 + dr) * 64 + 16 + 15 - qc + bs + 8 * g;
#pragma unroll
            for (int tau = 0; tau < 2; ++tau)
#pragma unroll
                for (int rho = 0; rho < 4; ++rho) {
                    const int e = 4 * tau + rho, kc = bs + 8 * g + e;
                    const bool valid = (kc >= wst) && (kc < wst + 16);
                    const float v = valid ? sc[p][tau][rho] + rt[e] : -1.0e30f;
                    sc[p][tau][rho] = v; mx = fmaxf(mx, v);
                }
        }
#pragma unroll
        for (int p = 8; p < 16; ++p)
#pragma unroll
            for (int tau = 0; tau < 2; ++tau)
#pragma unroll
                for (int rho = 0; rho < 4; ++rho) mx = fmaxf(mx, sc[p][tau][rho]);
        mx = fmaxf(mx, __shfl_xor(mx, 16)); mx = fmaxf(mx, __shfl_xor(mx, 32));
        float lsum = 0.f;
        bf16x8 pb[16];
#pragma unroll
        for (int p = 0; p < 16; ++p) {
            float pv[8];
#pragma unroll
            for (int tau = 0; tau < 2; ++tau)
#pragma unroll
                for (int rho = 0; rho < 4; ++rho) { const float e = __builtin_amdgcn_exp2f(sc[p][tau][rho] - mx); pv[4 * tau + rho] = e; lsum += e; }
            v4u w; w.x = pg8::cvt_pk_bf16(pv[0], pv[1]); w.y = pg8::cvt_pk_bf16(pv[2], pv[3]); w.z = pg8::cvt_pk_bf16(pv[4], pv[5]); w.w = pg8::cvt_pk_bf16(pv[6], pv[7]);
            pb[p] = __builtin_bit_cast(bf16x8, w);
        }
        lsum += __shfl_xor(lsum, 16); lsum += __shfl_xor(lsum, 32);
        f32x4 o[4];
#pragma unroll
        for (int dt = 0; dt < 4; ++dt) o[dt] = (f32x4){0.f, 0.f, 0.f, 0.f};
#pragma unroll
        for (int p = 0; p < 16; ++p) {
#pragma unroll
            for (int dt = 0; dt < 4; ++dt) {
                const int d = 16 * dt + l15;
                const bf16* vp = p < 8 ? VT + ((size_t)(b * 16 + h) * 64 + d) * 8192 + (size_t)(s0 + p) * 64 + bs + 8 * g
                                       : VCT + ((size_t)(b * 16 + h) * 64 + d) * 256 + 32 * (p - 8) + 8 * g;
                const bf16x8 vf = *(const bf16x8*)vp;
                o[dt] = __builtin_amdgcn_mfma_f32_16x16x32_bf16(vf, pb[p], o[dt], 0, 0, 0);
            }
        }
        const float inv = 1.0f / lsum;
#pragma unroll
        for (int dt = 0; dt < 4; ++dt) { v2u w; w.x = pk2(o[dt][0] * inv, o[dt][1] * inv); w.y = pk2(o[dt][2] * inv, o[dt][3] * inv);
            *(v2u*)(O + tq * D + h * 64 + 16 * dt + 4 * g) = w; }
    }
}

constexpr int N_PHASES = 15;
__global__ void __launch_bounds__(NWAVES * 64, 2) dit_fwd(Args args) {
    extern __shared__ __attribute__((aligned(16))) unsigned char lds[];
    Frame F;
    F.lds = (LAS unsigned char*)lds;
    F.tid = threadIdx.x; F.lane = F.tid & 63; F.wave = __builtin_amdgcn_readfirstlane(F.tid >> 6);
    F.G = gridDim.x; { const int bx = blockIdx.x; F.vcu = (F.G % 8 == 0) ? (bx % 8) * (F.G / 8) + bx / 8 : bx; }
    unsigned char* ws = args.ws; F.ws = ws; F.out = args.out;
    F.ctl = (gu32*)(ws + WS_CTL);
    volatile LAS unsigned* MISC = (volatile LAS unsigned*)(F.lds + MISC_OFF);
    for (int u = F.tid; u < (LDS_BYTES - LDSCTL_OFF) / 4; u += NWAVES * 64) ((LAS unsigned*)(F.lds + LDSCTL_OFF))[u] = 0u;
    __syncthreads();
    const int lo = args.ph_lo, hi = args.ph_hi;
    XcdBarrier bar; bar.bar = (unsigned*)(F.ctl + CW_BAR); bar.x = 0; bar.st = nullptr;
    if (hi - lo > 1) bar = xcd_barrier_post((unsigned*)(F.ctl + CW_BAR), MISC + 8);
#define IN(k) (lo <= (k) && (k) < hi)
#define SEAM(k) do { if (IN(k) && IN((k) + 1)) xcd_barrier(bar); } while (0)
#define mods ((float*)(ws + WS_MODS))
#define AD ((bf16*)(ws + WS_AD))
#define Y ((float*)(ws + WS_Y))
#define Gb ((bf16*)(ws + WS_G))
#define XC ((float*)(ws + WS_XC))
    const int c = (int)blockIdx.x;

    if (IN(0)) { p0_prologue(F); SEAM(0); }
    if (IN(1)) { p1_pool_operand(F); SEAM(1); }
    if (IN(2)) {
        pg8::Gemm g{AD, (const bf16*)(ws + WS_WPOOL), D, 256, 256, 256};
        pg8::Sched S{F.G, c, 0, 66, 4, 0, 0, 0, 0};
        pg8::EpiF32 E{Y, D};
        pg8::gemm_phase<pg8::EpiF32>(F.lds + RING_OFF, g, S, E);
        SEAM(2);
    }
    if (IN(3)) {
        RowPass P{Y, in_ptr(I_POOLS), in_ptr(I_MIXPOST), mods, 2, in_ptr(I_X), in_ptr(I_CTX), F.out, XC, AD, in_ptr(I_FFNPRE), mods, 3, 4, M_T};
        row_pass(F, P); SEAM(3);
    }
    if (IN(4)) {
        pg8::Gemm g{AD, (const bf16*)(ws + WS_WUP), D, D, D, 0};
        pg8::Sched S{F.G, c, 1, 68, 22, 0, 0, 0, 0};
        pg8::EpiConvAct E{Gb, in_ptr(I_CONVW), in_ptr(I_CONVB)};
        pg8::gemm_phase<pg8::EpiConvAct>(F.lds + RING_OFF, g, S, E);
        SEAM(4);
    }
    if (IN(5)) {
        pg8::Gemm g{Gb, (const bf16*)(ws + WS_WDN), DFF, DFF, DFF, 0};
        pg8::Sched S{F.G, c, 0, 66, 4, 0, 0, 0, 0};
        pg8::EpiF32 E{Y, D};
        pg8::gemm_phase<pg8::EpiF32>(F.lds + RING_OFF, g, S, E);
        SEAM(5);
    }
    if (IN(6)) {
        RowPass P{Y, nullptr, in_ptr(I_FFNPOST), mods, 5, F.out, XC, F.out, XC, AD, in_ptr(I_MIXPRE) + D, mods + 3 * ADA, 0, 1, M_T};
        row_pass(F, P); SEAM(6);
    }
    if (IN(7)) {
        pg8::Gemm g{AD, (const bf16*)(ws + WS_WQKV), D, D, D, 0};
        pg8::Sched S{F.G, c, 0, 64, 12, 2, 8, 64, 4};
        pg8::EpiQKV E{(bf16*)(ws + WS_Q), ((long)WS_K - (long)WS_Q) / 2, ((long)WS_V - (long)WS_K) / 2, QSCALE};
        pg8::gemm_phase<pg8::EpiQKV>(F.lds + RING_OFF, g, S, E);
        SEAM(7);
    }
    if (IN(8)) { p8_vtranspose(F); SEAM(8); }
    if (IN(9)) { p9_attention(F); SEAM(9); }
    if (IN(10)) {
        pg8::Gemm g{(const bf16*)(ws + WS_Q), (const bf16*)(ws + WS_WO), D, D, D, 0};
        pg8::Sched S{F.G, c, 0, 64, 4, 0, 0, 0, 0};
        pg8::EpiF32 E{Y, D};
        pg8::gemm_phase<pg8::EpiF32>(F.lds + RING_OFF, g, S, E);
        SEAM(10);
    }
    if (IN(11)) {
        RowPass P{Y, nullptr, in_ptr(I_MIXPOST) + D, mods + 3 * ADA, 2, F.out, XC, F.out, XC, AD, in_ptr(I_FFNPRE) + D, mods + 3 * ADA, 3, 4, M_X};
        row_pass(F, P); SEAM(11);
    }
    if (IN(12)) {
        pg8::Gemm g{AD, (const bf16*)(ws + WS_WUP) + (size_t)NUP * D, D, D, D, 0};
        pg8::Sched S{F.G, c, 1, 66, 22, 0, 0, 0, 0};
        pg8::EpiConvAct E{Gb, in_ptr(I_CONVW) + 3 * NUP, in_ptr(I_CONVB) + NUP};
        pg8::gemm_phase<pg8::EpiConvAct>(F.lds + RING_OFF, g, S, E);
        SEAM(12);
    }
    if (IN(13)) {
        pg8::Gemm g{Gb, (const bf16*)(ws + WS_WDN) + (size_t)D * DFF, DFF, DFF, DFF, 0};
        pg8::Sched S{F.G, c, 0, 64, 4, 0, 0, 0, 0};
        pg8::EpiF32 E{Y, D};
        pg8::gemm_phase<pg8::EpiF32>(F.lds + RING_OFF, g, S, E);
        SEAM(13);
    }
    if (IN(14)) {
        RowPass P{Y, nullptr, in_ptr(I_FFNPOST) + D, mods + 3 * ADA, 5, F.out, XC, F.out, XC, nullptr, nullptr, nullptr, 0, 0, M_X};
        row_pass(F, P);
    }
#undef IN
#undef SEAM
#undef mods
#undef AD
#undef Y
#undef Gb
#undef XC
}

extern "C" void kernel_launch(void* const* d_in, const int* in_sizes, int n_in, void* d_out, int out_size, void* d_ws, size_t ws_size, hipStream_t stream) {
    static int grid = 0;
    if (grid == 0) {
        if (n_in != 19 || in_sizes[0] != M_X * D || out_size != M_X * D || ws_size < WS_END) { fprintf(stderr, "kernel_launch: unexpected shapes (n_in %d, in0 %d, out %d, ws %zu)\n", n_in, n_in > 0 ? in_sizes[0] : -1, out_size, ws_size); grid = -1; return; }
        int dev = 0, cus = 0, per_cu = 0;
        if (hipGetDevice(&dev) != hipSuccess || hipDeviceGetAttribute(&cus, hipDeviceAttributeMultiprocessorCount, dev) != hipSuccess) { grid = -1; return; }
        if (hipFuncSetAttribute((const void*)dit_fwd, hipFuncAttributeMaxDynamicSharedMemorySize, LDS_BYTES) != hipSuccess) { fprintf(stderr, "kernel_launch: hipFuncSetAttribute failed\n"); grid = -1; return; }
        if (hipOccupancyMaxActiveBlocksPerMultiprocessor(&per_cu, (const void*)dit_fwd, NWAVES * 64, LDS_BYTES) != hipSuccess || per_cu < 1) { fprintf(stderr, "kernel_launch: occupancy query reports %d blocks per CU\n", per_cu); }
        (void)hipGetLastError();
        grid = cus;
    }
    if (grid < 0) return;
    if (hipMemsetAsync((char*)d_ws + WS_CTL, 0, CTL_ZERO_BYTES, stream) != hipSuccess) { fprintf(stderr, "kernel_launch: memset failed\n"); return; }
    Args a{};
    for (int i = 0; i < 19; ++i) a.in[i] = (const float*)d_in[i];
    a.out = (float*)d_out; a.ws = (unsigned char*)d_ws;
#if MK_N_LAUNCHES == 1
    a.ph_lo = 0; a.ph_hi = N_PHASES;
    hipLaunchKernelGGL(dit_fwd, dim3(grid), dim3(NWAVES * 64), LDS_BYTES, stream, a);
#else
    for (int p = 0; p < N_PHASES; ++p) { a.ph_lo = p; a.ph_hi = p + 1; hipLaunchKernelGGL(dit_fwd, dim3(grid), dim3(NWAVES * 64), LDS_BYTES, stream, a); }
#endif
    const hipError_t le = hipPeekAtLastError();
    if (le != hipSuccess) fprintf(stderr, "kernel_launch: launch failed: %s (grid %d)\n", hipGetErrorName(le), grid);
}
```

```cpp
#include <hip/hip_runtime.h>
#include <cstdio>
#include <cstdint>

#ifndef MK_N_LAUNCHES
#define MK_N_LAUNCHES 1
#endif

constexpr int D = 1024, SEQ = 8192, M_X = 16384, CTXL = 256, M_T = 16896;
constexpr int DFF = 2816, NUP = 5632, NHEAD = 16, ADA = 6144;
constexpr float EPS = 1e-6f;
constexpr float LOG2E = 1.4426950408889634f;
constexpr float QSCALE = 0.125f * LOG2E;

constexpr size_t MiB = 1u << 20;
constexpr size_t WS_CTL = 0, CTL_ZERO_BYTES = 1 * MiB;
constexpr size_t WS_MODS = 1 * MiB;
constexpr size_t WS_RPB = 1 * MiB + 256 * 1024;
constexpr size_t WS_XC = 2 * MiB;
constexpr size_t WS_WPOOL = 4 * MiB;
constexpr size_t WS_WQKV = 5 * MiB;
constexpr size_t WS_WO = 11 * MiB;
constexpr size_t WS_WUP = 13 * MiB;
constexpr size_t WS_WDN = 35 * MiB;
constexpr size_t WS_AD = 46 * MiB;
constexpr size_t WS_Y = 79 * MiB;
constexpr size_t WS_G = 145 * MiB;
constexpr size_t WS_Q = WS_G, WS_K = WS_G + 33 * MiB, WS_V = WS_Y, WS_VT = WS_Y + 33 * MiB;
constexpr size_t WS_END = WS_G + (size_t)M_T * DFF * 2;
static_assert(WS_END <= 256 * MiB, "workspace map");
static_assert(WS_K + 33 * MiB <= WS_END && WS_VT + 33 * MiB <= WS_G, "overlays");

constexpr int CW_TMO = 0, CW_QUEUE = 64, CW_BAR = 4096;

namespace pg8 {
#define PG8_LAS __attribute__((address_space(3)))
typedef unsigned short bf16_t;
typedef short bf16x8 __attribute__((ext_vector_type(8)));
typedef float f32x4 __attribute__((ext_vector_type(4)));
typedef unsigned u32x4 __attribute__((ext_vector_type(4)));
typedef unsigned u32x2 __attribute__((ext_vector_type(2)));
constexpr int BM = 256, BK = 64, HALF = 128, HTB = HALF * BK * 2, STAGE_BYTES = 8 * HTB, NXCD = 8, WGM = 8;

__host__ __device__ __forceinline__ int lds_byte(int r, int c) { const int st = (r >> 4) * 2 + (c >> 5), rr = r & 15, cc = c & 31, ob = rr * 64 + cc * 2; return st * 1024 + (ob ^ (((ob >> 9) & 1) << 5)); }
__host__ __device__ __forceinline__ void stage_rc(int b, int& R, int& C) { const int st = b / 1024, sb = b % 1024, swz = sb ^ (((sb >> 9) & 1) << 5); R = (st >> 1) * 16 + swz / 64; C = (st & 1) * 32 + (swz % 64) / 2; }
__host__ __device__ __forceinline__ int perm32(int rho) { const int n = rho >> 4, i = rho & 15; return 8 * (i >> 2) + 4 * n + (i & 3); }

struct Unit { int arow, pn, flags; };
struct Gemm { const bf16_t* A; const bf16_t* Bt; int lda, ldb, K, a_pn_off; };

struct Sched {
    int G, c, mode;
    int nM1, nN1, nM2, nN2, rt2, pn2;
    __device__ __forceinline__ static void swz(int L, int nM, int nN, int& tm, int& pn) {
        const int nwg = nM * nN; int wgid = L; { const int q = nwg / NXCD, r = nwg % NXCD, xcd = wgid % NXCD, off = wgid / NXCD; wgid = (xcd < r ? xcd * (q + 1) : r * (q + 1) + (xcd - r) * q) + off; }
        const int nig = WGM * nN, gid = wgid / nig, fm = gid * WGM, gsz = (nM - fm) < WGM ? (nM - fm) : WGM;
        tm = fm + ((wgid % nig) % gsz); pn = (wgid % nig) / gsz;
    }
    __device__ __forceinline__ bool next(int i, Unit& u) const {
        const long L = (long)i * G + c; const int n1 = nM1 * nN1, n2 = nM2 * nN2; int tm, pn;
        if (L < n1) {
            swz((int)L, nM1, nN1, tm, pn); u.pn = pn;
            if (mode == 0) { u.arow = 256 * tm; u.flags = 0; }
            else if (tm < 66) { const int sq = tm / 33, k = tm - 33 * sq; const int s = 254 * k < 7936 ? 254 * k : 7936; u.arow = sq * 8192 + s; u.flags = (k == 0 ? 1 : 0) | (k == 32 ? 2 : 0); }
            else { u.arow = 16384 + 256 * (tm - 66); u.flags = 3; }
            return true;
        }
        if (L < n1 + n2) { swz((int)(L - n1), nM2, nN2, tm, pn); u.arow = 256 * (rt2 + tm); u.pn = pn2 + pn; u.flags = 0; return true; }
        return false;
    }
};

__device__ __forceinline__ unsigned cvt_pk_bf16(float lo, float hi) { unsigned r; asm volatile("v_cvt_pk_bf16_f32 %0, %1, %2" : "=v"(r) : "v"(lo), "v"(hi)); return r; }

struct EpiF32 {
    static constexpr bool PERM = false, USES_LDS = false;
    float* C; int ldc;
    __device__ __forceinline__ void operator()(const f32x4 (&acc)[2][2][4][2], const Unit& u, int wr, int wc, int fr, int fq) const {
        const int row0 = u.arow + wr * 64 + fr, col0 = u.pn * BM + wc * 32 + 4 * fq;
#pragma unroll
        for (int ai = 0; ai < 2; ++ai)
#pragma unroll
            for (int m = 0; m < 4; ++m) { float* rowp = C + (size_t)(row0 + ai * HALF + m * 16) * ldc + col0;
#pragma unroll
                for (int bj = 0; bj < 2; ++bj)
#pragma unroll
                    for (int n = 0; n < 2; ++n) *(f32x4*)(rowp + bj * HALF + n * 16) = acc[ai][bj][m][n]; }
    }
};
struct EpiQKV {
    static constexpr bool PERM = true, USES_LDS = false;
    bf16_t* Oq; long dk, dv; float scale0;
    __device__ __forceinline__ void operator()(const f32x4 (&acc)[2][2][4][2], const Unit& u, int wr, int wc, int fr, int fq) const {
        const int t = u.pn >> 2; bf16_t* base = Oq + (t >= 1 ? dk : 0l) + (t >= 2 ? dv : 0l); const float sc = t == 0 ? scale0 : 1.f;
        const int row0 = u.arow + wr * 64 + fr, col0 = (u.pn & 3) * BM + wc * 32 + 8 * fq;
#pragma unroll
        for (int ai = 0; ai < 2; ++ai)
#pragma unroll
            for (int m = 0; m < 4; ++m) { bf16_t* rowp = base + (size_t)(row0 + ai * HALF + m * 16) * 1024 + col0;
#pragma unroll
                for (int bj = 0; bj < 2; ++bj) { const f32x4 v0 = acc[ai][bj][m][0] * sc, v1 = acc[ai][bj][m][1] * sc;
                    u32x4 w; w.x = cvt_pk_bf16(v0[0], v0[1]); w.y = cvt_pk_bf16(v0[2], v0[3]); w.z = cvt_pk_bf16(v1[0], v1[1]); w.w = cvt_pk_bf16(v1[2], v1[3]);
                    *(u32x4*)(rowp + bj * HALF) = w; } }
    }
};
__device__ __forceinline__ float dpp_up(float v) { return __builtin_bit_cast(float, __builtin_amdgcn_update_dpp(0, __builtin_bit_cast(int, v), 0x121, 0xf, 0xf, false)); }
__device__ __forceinline__ float dpp_dn(float v) { return __builtin_bit_cast(float, __builtin_amdgcn_update_dpp(0, __builtin_bit_cast(int, v), 0x12F, 0xf, 0xf, false)); }
__device__ __forceinline__ float gelu_tanh(float v) {
    const float z = v * (1.5957691216f + 0.0713548163f * v * v);
    const float e = __builtin_amdgcn_exp2f(-LOG2E * z);
    return v * __builtin_amdgcn_rcpf(1.0f + e);
}
struct EpiConvAct {
    static constexpr bool PERM = true, USES_LDS = true;
    bf16_t* Gout; const float* cw; const float* cb;
    __device__ __forceinline__ void run(const f32x4 (&acc)[2][2][4][2], const Unit& u, int wr, int wc, int fr, int fq, PG8_LAS unsigned char* ldsx) const {
        PG8_LAS float* E = (PG8_LAS float*)ldsx;
        const int cih = wc * 32 + 8 * fq;
#pragma unroll
        for (int ai = 0; ai < 2; ++ai) { const int blk = 2 * ai + wr;
#pragma unroll
            for (int bj = 0; bj < 2; ++bj)
#pragma unroll
                for (int n = 0; n < 2; ++n) {
                    if (fr == 0)  *(PG8_LAS f32x4*)(E + (blk * 2 + 0) * 256 + bj * 128 + cih + 4 * n) = acc[ai][bj][0][n];
                    if (fr == 15) *(PG8_LAS f32x4*)(E + (blk * 2 + 1) * 256 + bj * 128 + cih + 4 * n) = acc[ai][bj][3][n];
                } }
        asm volatile("s_waitcnt lgkmcnt(0)" ::: "memory"); __builtin_amdgcn_s_barrier(); asm volatile("" ::: "memory");
        const int gcol0 = u.pn * 128 + cih;
        const bool first = (u.flags & 1) != 0, last = (u.flags & 2) != 0;
        u32x2 keep[2][4];
#pragma unroll
        for (int n = 0; n < 2; ++n) {
            const int gc = gcol0 + 4 * n;
            const f32x4 wg0 = *(const f32x4*)(cw + gc), wg1 = *(const f32x4*)(cw + NUP + gc), wg2 = *(const f32x4*)(cw + 2 * NUP + gc), bg = *(const f32x4*)(cb + gc);
            const f32x4 wv0 = *(const f32x4*)(cw + DFF + gc), wv1 = *(const f32x4*)(cw + NUP + DFF + gc), wv2 = *(const f32x4*)(cw + 2 * NUP + DFF + gc), bv = *(const f32x4*)(cb + DFF + gc);
#pragma unroll
            for (int ai = 0; ai < 2; ++ai) { const int blk = 2 * ai + wr;
                f32x4 upg = {0.f, 0.f, 0.f, 0.f}, upv = upg, dng = upg, dnv = upg;
                if (blk > 0) { upg = *(PG8_LAS f32x4*)(E + ((blk - 1) * 2 + 1) * 256 + cih + 4 * n); upv = *(PG8_LAS f32x4*)(E + ((blk - 1) * 2 + 1) * 256 + 128 + cih + 4 * n); }
                if (blk < 3) { dng = *(PG8_LAS f32x4*)(E + ((blk + 1) * 2 + 0) * 256 + cih + 4 * n); dnv = *(PG8_LAS f32x4*)(E + ((blk + 1) * 2 + 0) * 256 + 128 + cih + 4 * n); }
#pragma unroll
                for (int m = 0; m < 4; ++m) {
                    const f32x4 cg = acc[ai][0][m][n], cv = acc[ai][1][m][n];
                    float og[4];
#pragma unroll
                    for (int e = 0; e < 4; ++e) {
                        float ug = dpp_up(cg[e]), uv = dpp_up(cv[e]), dg = dpp_dn(cg[e]), dv = dpp_dn(cv[e]);
                        const float pg = m > 0 ? dpp_up(acc[ai][0][m > 0 ? m - 1 : 0][n][e]) : upg[e], pv = m > 0 ? dpp_up(acc[ai][1][m > 0 ? m - 1 : 0][n][e]) : upv[e];
                        const float ng = m < 3 ? dpp_dn(acc[ai][0][m < 3 ? m + 1 : 3][n][e]) : dng[e], nv = m < 3 ? dpp_dn(acc[ai][1][m < 3 ? m + 1 : 3][n][e]) : dnv[e];
                        if (fr == 0) { ug = pg; uv = pv; }
                        if (fr == 15) { dg = ng; dv = nv; }
                        const float hg = bg[e] + wg0[e] * ug + wg1[e] * cg[e] + wg2[e] * dg;
                        const float hv = bv[e] + wv0[e] * uv + wv1[e] * cv[e] + wv2[e] * dv;
                        og[e] = gelu_tanh(hg) * hv;
                    }
                    u32x2 w; w.x = cvt_pk_bf16(og[0], og[1]); w.y = cvt_pk_bf16(og[2], og[3]);
                    if (n == 0) keep[ai][m] = w;
                    else {
                        const int tr = 128 * ai + 64 * wr + 16 * m + fr;
                        const bool ok = (tr >= 1 && tr <= 254) || (tr == 0 && first) || (tr == 255 && last);
                        if (ok) { u32x4 o; o.x = keep[ai][m].x; o.y = keep[ai][m].y; o.z = w.x; o.w = w.y; *(u32x4*)(Gout + (size_t)(u.arow + tr) * DFF + gcol0) = o; }
                    }
                }
            }
        }
    }
};

template <class Epi, bool ALIGN_EPI = true>
__device__ __forceinline__ void gemm_phase(PG8_LAS unsigned char* lds, const Gemm g, const Sched& S, const Epi& E) {
    const int tid = threadIdx.x, wid = __builtin_amdgcn_readfirstlane(tid >> 6), lane = tid & 63, wr = wid >> 2, wc = wid & 3, fr = lane & 15, fq = lane >> 4;
    const int K = g.K, nt = K / BK;
    unsigned voffA[2], voffB[2];
#pragma unroll
    for (int i = 0; i < 2; ++i) { int R, C; stage_rc(tid * 16 + i * 8192, R, C); const int Rb = Epi::PERM ? ((R & ~31) + perm32(R & 31)) : R;
        voffA[i] = (unsigned)(R * g.lda + C) * 2u; voffB[i] = (unsigned)(Rb * g.ldb + C) * 2u; }
    const size_t kstep = (size_t)(BK * 2);
    const size_t hstepA = (size_t)HALF * g.lda * 2, hstepB = (size_t)HALF * g.ldb * 2;
    const unsigned ldsw = (unsigned)wid * 1024u;
    const int aoff = lds_byte(wr * 64 + fr, fq * 8), boff = lds_byte(wc * 32 + fr, fq * 8);
#define PG8_SA(b, h) (((b) * 2 + (h)) * HTB)
#define PG8_SB(b, h) ((4 + (b) * 2 + (h)) * HTB)
#define PG8_STAGE(bufoff, gbase, voff) do { _Pragma("unroll") for (int _i = 0; _i < 2; ++_i) \
        __builtin_amdgcn_global_load_lds((const unsigned*)((const char*)(gbase) + (voff)[_i]), (PG8_LAS unsigned*)(lds + (bufoff) + ldsw + _i * 8192), 16, 0, 0); } while (0)
#define PG8_LDA(dst, b, h) do { _Pragma("unroll") for (int m = 0; m < 4; ++m) _Pragma("unroll") for (int k = 0; k < 2; ++k) dst[m][k] = *(const PG8_LAS bf16x8*)(lds + PG8_SA(b, h) + aoff + m * 2048 + k * 1024); } while (0)
#define PG8_LDB(dst, b, h) do { _Pragma("unroll") for (int n = 0; n < 2; ++n) _Pragma("unroll") for (int k = 0; k < 2; ++k) dst[n][k] = *(const PG8_LAS bf16x8*)(lds + PG8_SB(b, h) + boff + n * 2048 + k * 1024); } while (0)
#define PG8_MMA(ai, bj, At, Bt) do { __builtin_amdgcn_s_setprio(1); _Pragma("unroll") for (int m = 0; m < 4; ++m) _Pragma("unroll") for (int n = 0; n < 2; ++n) _Pragma("unroll") for (int k = 0; k < 2; ++k) \
        acc[ai][bj][m][n] = __builtin_amdgcn_mfma_f32_16x16x32_bf16(Bt[n][k], At[m][k], acc[ai][bj][m][n], 0, 0, 0); __builtin_amdgcn_s_setprio(0); } while (0)
#define PG8_WAIT_V(n) asm volatile("s_waitcnt vmcnt(" #n ")" ::: "memory")
#define PG8_WAIT_L(n) asm volatile("s_waitcnt lgkmcnt(" #n ")" ::: "memory")
#define PG8_BAR __builtin_amdgcn_s_barrier()
#define PG8_SCHED __builtin_amdgcn_sched_barrier(0)
    Unit cur, nxt; int ui = 0;
    if (!S.next(0, cur)) return;
    f32x4 acc[2][2][4][2];
#pragma unroll
    for (int a = 0; a < 2; ++a)
#pragma unroll
        for (int b = 0; b < 2; ++b)
#pragma unroll
            for (int m = 0; m < 4; ++m)
#pragma unroll
                for (int n = 0; n < 2; ++n) acc[a][b][m][n] = (f32x4){0.f, 0.f, 0.f, 0.f};
    bf16x8 At[4][2], B0[2][2], B1[2][2];
    const char* cA = (const char*)g.A + ((size_t)cur.arow * g.lda + (size_t)cur.pn * g.a_pn_off) * 2; const char* cB = (const char*)g.Bt + (size_t)cur.pn * BM * g.ldb * 2;
    PG8_STAGE(PG8_SB(0, 0), cB, voffB); PG8_STAGE(PG8_SB(0, 1), cB + hstepB, voffB); PG8_STAGE(PG8_SA(0, 0), cA, voffA); PG8_STAGE(PG8_SA(0, 1), cA + hstepA, voffA);
    if (wr == 1) PG8_BAR;
    PG8_WAIT_V(2); PG8_BAR;
    PG8_STAGE(PG8_SB(1, 0), cB + kstep, voffB); PG8_STAGE(PG8_SA(1, 0), cA + kstep, voffA); PG8_STAGE(PG8_SB(1, 1), cB + hstepB + kstep, voffB);
    PG8_WAIT_V(6); PG8_BAR;
    for (;;) {
        const bool has_next = S.next(ui + 1, nxt);
        const char* nA = has_next ? (const char*)g.A + ((size_t)nxt.arow * g.lda + (size_t)nxt.pn * g.a_pn_off) * 2 : cA; const char* nB = has_next ? (const char*)g.Bt + (size_t)nxt.pn * BM * g.ldb * 2 : cB;
        for (int t = 0; t < nt; t += 2) {
            const bool last = (t == nt - 2);
            const char* a1 = cA + (size_t)(t + 1) * kstep;
            const char* a2 = last ? nA : cA + (size_t)(t + 2) * kstep; const char* b2 = last ? nB : cB + (size_t)(t + 2) * kstep;
            const char* a3 = a2 + kstep; const char* b3 = b2 + kstep;
            PG8_LDB(B0, 0, 0); PG8_LDB(B1, 0, 1); PG8_SCHED; PG8_LDA(At, 0, 0); PG8_STAGE(PG8_SA(1, 1), a1 + hstepA, voffA);
            PG8_WAIT_V(8); PG8_WAIT_L(0); PG8_BAR; PG8_MMA(0, 0, At, B0); PG8_MMA(0, 1, At, B1); PG8_BAR; PG8_SCHED;
            PG8_LDA(At, 0, 1); PG8_STAGE(PG8_SB(0, 0), b2, voffB); PG8_STAGE(PG8_SB(0, 1), b2 + hstepB, voffB); PG8_STAGE(PG8_SA(0, 0), a2, voffA);
            PG8_WAIT_V(8); PG8_WAIT_L(0); PG8_BAR; PG8_MMA(1, 0, At, B0); PG8_MMA(1, 1, At, B1); PG8_BAR; PG8_SCHED;
            PG8_LDB(B0, 1, 0); PG8_LDB(B1, 1, 1); PG8_SCHED; PG8_LDA(At, 1, 0); PG8_STAGE(PG8_SA(0, 1), a2 + hstepA, voffA);
            PG8_WAIT_V(8); PG8_WAIT_L(0); PG8_BAR; PG8_MMA(0, 0, At, B0); PG8_MMA(0, 1, At, B1); PG8_BAR; PG8_SCHED;
            PG8_LDA(At, 1, 1); PG8_STAGE(PG8_SB(1, 0), b3, voffB); PG8_STAGE(PG8_SB(1, 1), b3 + hstepB, voffB); PG8_STAGE(PG8_SA(1, 0), a3, voffA);
            PG8_WAIT_V(8); PG8_WAIT_L(0); PG8_BAR; PG8_MMA(1, 0, At, B0); PG8_MMA(1, 1, At, B1); PG8_BAR; PG8_SCHED;
        }
        if constexpr (ALIGN_EPI) { if (wr == 0) PG8_BAR; }
        if constexpr (Epi::USES_LDS) E.run(acc, cur, wr, wc, fr, fq, lds + STAGE_BYTES); else E(acc, cur, wr, wc, fr, fq);
        if (!has_next) break;
#pragma unroll
        for (int a = 0; a < 2; ++a)
#pragma unroll
            for (int b = 0; b < 2; ++b)
#pragma unroll
                for (int m = 0; m < 4; ++m)
#pragma unroll
                    for (int n = 0; n < 2; ++n) acc[a][b][m][n] = (f32x4){0.f, 0.f, 0.f, 0.f};
        cur = nxt; cA = nA; cB = nB; ++ui;
        if constexpr (ALIGN_EPI) { if (wr == 1) PG8_BAR; }
    }
    PG8_WAIT_V(0);
    if constexpr (!ALIGN_EPI) { if (wr == 0) PG8_BAR; }
    PG8_BAR;
#undef PG8_SA
#undef PG8_SB
#undef PG8_STAGE
#undef PG8_LDA
#undef PG8_LDB
#undef PG8_MMA
#undef PG8_WAIT_V
#undef PG8_WAIT_L
#undef PG8_BAR
#undef PG8_SCHED
}
}

constexpr int RING_OFF = 0, RING_BYTES = 131072;
constexpr int EDGE_OFF = RING_BYTES, EDGE_BYTES = 8192;
constexpr int LDSCTL_OFF = EDGE_OFF + EDGE_BYTES, MISC_OFF = LDSCTL_OFF + 320;
constexpr int LDS_BYTES = 147456;
static_assert(MISC_OFF + 128 <= LDS_BYTES, "LDS map");
constexpr int NWAVES = 8;

#define GAS __attribute__((address_space(1)))
#define LAS __attribute__((address_space(3)))
typedef unsigned short bf16;
typedef unsigned v4u __attribute__((ext_vector_type(4)));
typedef unsigned v2u __attribute__((ext_vector_type(2)));
typedef float f32x4 __attribute__((ext_vector_type(4)));
typedef short bf16x8 __attribute__((ext_vector_type(8)));
typedef GAS unsigned gu32;
#define RLX_AGENT __ATOMIC_RELAXED, __HIP_MEMORY_SCOPE_AGENT
#define LDS_WAIT() asm volatile("s_waitcnt lgkmcnt(0)" ::: "memory")
#define VM_WAIT() asm volatile("s_waitcnt vmcnt(0)" ::: "memory")
__device__ __forceinline__ unsigned f2bf(float f) { unsigned u = __builtin_bit_cast(unsigned, f); return (u + 0x7fffu + ((u >> 16) & 1u)) >> 16; }
__device__ __forceinline__ unsigned pk2(float lo, float hi) { return f2bf(lo) | (f2bf(hi) << 16); }

#define XB_TMO      128
#define XB_XCNT(j)  (256  + 64 * (j))
#define XB_XSUB(j)  (1280 + 64 * (j))
#define XB_XGEN(j)  (2304 + 64 * (j))
#define XB_TOP      3328
#define XB_TOPGEN   3392
#define XCD_BAR_WORDS 3456
#define XB_SPIN_CAP (1u << 18)
__device__ __forceinline__ unsigned xb_ld(unsigned* p)              { return __hip_atomic_load(p, __ATOMIC_RELAXED, __HIP_MEMORY_SCOPE_AGENT); }
__device__ __forceinline__ unsigned xb_add(unsigned* p, unsigned v) { return __hip_atomic_fetch_add(p, v, __ATOMIC_RELAXED, __HIP_MEMORY_SCOPE_AGENT); }
__device__ __forceinline__ unsigned xb_xcc_id() { return (unsigned)__builtin_amdgcn_s_getreg((3 << 11) | 20) & 0xFu; }
#define XB_SPIN(cond, bar) do { unsigned _sp = 0; while (cond) { __builtin_amdgcn_s_sleep(1); \
    if ((++_sp & 255u) == 0u) { if (xb_ld(&(bar)[XB_TMO])) break; if (_sp > XB_SPIN_CAP) { atomicAdd(&(bar)[XB_TMO], 1u); break; } } } } while (0)
struct XcdBarrier { unsigned* bar; unsigned x; volatile LAS unsigned* st; };
__device__ __forceinline__ XcdBarrier xcd_barrier_post(unsigned* bar, volatile LAS unsigned* st) {
    XcdBarrier b; b.bar = bar; b.x = xb_xcc_id(); b.st = st;
    if (threadIdx.x == 0) (void)xb_add(&bar[XB_XCNT(b.x)], 1u);
    return b;
}
__device__ __forceinline__ void xcd_barrier_complete(unsigned* bar, unsigned x, unsigned& nloc, unsigned& nx) {
    const unsigned G = gridDim.x * gridDim.y * gridDim.z;
    unsigned sum, cnt, mine, sp = 0u;
    for (;;) {
        sum = 0u; cnt = 0u; mine = 0u;
#pragma unroll
        for (unsigned j = 0; j < 16; ++j) { const unsigned c = xb_ld(&bar[XB_XCNT(j)]); sum += c; cnt += (c > 0u) ? 1u : 0u; mine = (j == x) ? c : mine; }
        if (sum == G) break;
        __builtin_amdgcn_s_sleep(1);
        if ((++sp & 255u) == 0u) { if (xb_ld(&bar[XB_TMO])) break; if (sp > XB_SPIN_CAP) { atomicAdd(&bar[XB_TMO], 1u); break; } }
    }
    nloc = mine > 0u ? mine : 1u; nx = cnt > 0u ? cnt : 1u;
}
__device__ __forceinline__ void xcd_barrier(const XcdBarrier& b) {
    asm volatile("s_waitcnt vmcnt(0)" ::: "memory");
    __syncthreads();
    if (threadIdx.x == 0) {
        unsigned* bar = b.bar;
        __builtin_amdgcn_s_waitcnt(0);
        unsigned nloc = b.st[0], nx = b.st[1];
        if (nloc == 0u) { xcd_barrier_complete(bar, b.x, nloc, nx); b.st[0] = nloc; b.st[1] = nx; }
        const unsigned old = xb_add(&bar[XB_XSUB(b.x)], 1u);
        const unsigned gen = old / nloc;
        if (old + 1u == (gen + 1u) * nloc) {
            __builtin_amdgcn_fence(__ATOMIC_RELEASE, "agent");
            asm volatile("s_waitcnt vmcnt(0)" ::: "memory");
            const unsigned og = xb_add(&bar[XB_TOP], 1u);
            const unsigned tg = og / nx;
            if (og + 1u == (tg + 1u) * nx) xb_add(&bar[XB_TOPGEN], 1u);
            else XB_SPIN(xb_ld(&bar[XB_TOPGEN]) == tg, bar);
            __builtin_amdgcn_fence(__ATOMIC_ACQUIRE, "agent");
            xb_add(&bar[XB_XGEN(b.x)], 1u);
            asm volatile("s_waitcnt vmcnt(0)" ::: "memory");
        } else {
            XB_SPIN(xb_ld(&bar[XB_XGEN(b.x)]) == gen, bar);
            __builtin_amdgcn_fence(__ATOMIC_ACQUIRE, "agent");
            asm volatile("s_waitcnt vmcnt(0)" ::: "memory");
        }
    }
    __syncthreads();
}

struct Args { const float* in[19]; float* out; unsigned char* ws; int ph_lo, ph_hi; };
struct Frame {
    LAS unsigned char* lds;
    gu32* ctl;
    int tid, lane, wave, vcu, G;
    float* out; unsigned char* ws;
};
typedef __attribute__((address_space(4))) const char* kernarg_cptr;
__device__ __forceinline__ const float* in_ptr(int i) { kernarg_cptr kp = (kernarg_cptr)__builtin_amdgcn_kernarg_segment_ptr(); asm volatile("" : "+s"(kp)); return *(const float* __attribute__((address_space(4))) const*)(kp + 8 * i); }
enum { I_X = 0, I_C, I_CTX, I_CCTX, I_ADAW, I_ADAB, I_MIXPRE, I_MIXPOST, I_FFNPRE, I_FFNPOST, I_POOLW, I_POOLS, I_WQKV, I_WO, I_RPB, I_WUP, I_CONVW, I_CONVB, I_WDOWN };
__device__ __forceinline__ float wave_sum(float v) {
#pragma unroll
    for (int o = 1; o < 64; o <<= 1) v += __shfl_xor(v, o);
    return v;
}
__device__ __forceinline__ float silu(float v) { return v / (1.0f + __expf(-v)); }

__device__ __forceinline__ void p0_transpose_item(const float* W, int ldw, int k0, int n0, bf16* WT, int ldwt, int dst_row0, LAS float* scr, int lane) {
#pragma unroll 8
    for (int i = 0; i < 32; ++i) { const int kk = 2 * i + (lane >> 5); scr[kk * 33 + (lane & 31)] = W[(size_t)(k0 + kk) * ldw + n0 + (lane & 31)]; }
    LDS_WAIT(); asm volatile("" ::: "memory");
    const int c = lane & 7;
#pragma unroll
    for (int j = 0; j < 4; ++j) { const int n = (lane >> 3) + 8 * j; const LAS float* s = scr + (8 * c) * 33 + n;
        v4u o; o.x = pk2(s[0 * 33], s[1 * 33]); o.y = pk2(s[2 * 33], s[3 * 33]); o.z = pk2(s[4 * 33], s[5 * 33]); o.w = pk2(s[6 * 33], s[7 * 33]);
        *(GAS v4u*)(WT + (size_t)(dst_row0 + n) * ldwt + k0 + 8 * c) = o; }
    LDS_WAIT(); asm volatile("" ::: "memory");
}
__device__ __forceinline__ void p0_convert_item(Frame& F, int it, LAS float* scr) {
    if (it < 128) { const int g = it >> 5, r = it & 31, kb = r >> 3, nb = r & 7;
        p0_transpose_item(in_ptr(I_POOLW) + (size_t)g * 65536, 256, 64 * kb, 32 * nb, (bf16*)(F.ws + WS_WPOOL), 256, g * 256 + 32 * nb, scr, F.lane); return; }
    it -= 128;
    if (it < 1536) { const int kb = it / 96, nb = it % 96; p0_transpose_item(in_ptr(I_WQKV), 3072, 64 * kb, 32 * nb, (bf16*)(F.ws + WS_WQKV), 1024, 32 * nb, scr, F.lane); return; }
    it -= 1536;
    if (it < 512) { const int kb = it / 32, nb = it % 32; p0_transpose_item(in_ptr(I_WO), 1024, 64 * kb, 32 * nb, (bf16*)(F.ws + WS_WO), 1024, 32 * nb, scr, F.lane); return; }
    it -= 512;
    if (it < 5632) { const int l = it / 2816, r = it % 2816, kb = r / 176, nb = r % 176; const int n0 = 32 * nb;
        const int half = n0 >= DFF ? 1 : 0, nn = n0 - half * DFF; const int drow = 256 * (nn >> 7) + 128 * half + (nn & 127);
        p0_transpose_item(in_ptr(I_WUP) + (size_t)l * D * NUP, NUP, 64 * kb, n0, (bf16*)(F.ws + WS_WUP) + (size_t)l * NUP * D, 1024, drow, scr, F.lane); return; }
    it -= 5632;
    { const int l = it / 1408, r = it % 1408, kb = r / 32, nb = r % 32;
      p0_transpose_item(in_ptr(I_WDOWN) + (size_t)l * DFF * D, D, 64 * kb, 32 * nb, (bf16*)(F.ws + WS_WDN) + (size_t)l * D * DFF, DFF, 32 * nb, scr, F.lane); }
}
constexpr int N_CONV_ITEMS = 128 + 1536 + 512 + 5632 + 2816;
__device__ __forceinline__ void p0_prologue(Frame& F) {
    const int bid = blockIdx.x;
    float* mods = (float*)(F.ws + WS_MODS);
    if (bid < 192) {
        const float* pc = in_ptr(I_C); const float* pcc = in_ptr(I_CCTX); const float* padaw = in_ptr(I_ADAW); const float* padab = in_ptr(I_ADAB);
        const int l = bid / 96, ch = bid % 96, col = 64 * ch + F.lane, kb = 128 * F.wave;
        float cv[3][2];
#pragma unroll
        for (int h = 0; h < 2; ++h) { cv[0][h] = silu(pc[kb + 64 * h + F.lane]); cv[1][h] = silu(pc[D + kb + 64 * h + F.lane]); cv[2][h] = silu(pcc[kb + 64 * h + F.lane]); }
        const float* W = padaw + (size_t)l * D * ADA + (size_t)kb * ADA + col;
        float a0 = 0.f, a1 = 0.f, a2 = 0.f;
#pragma unroll
        for (int h = 0; h < 2; ++h)
#pragma unroll 16
            for (int kk = 0; kk < 64; ++kk) {
                const float w = W[(size_t)(64 * h + kk) * ADA];
                a0 += __builtin_bit_cast(float, __builtin_amdgcn_readlane(__builtin_bit_cast(int, cv[0][h]), kk)) * w;
                a1 += __builtin_bit_cast(float, __builtin_amdgcn_readlane(__builtin_bit_cast(int, cv[1][h]), kk)) * w;
                a2 += __builtin_bit_cast(float, __builtin_amdgcn_readlane(__builtin_bit_cast(int, cv[2][h]), kk)) * w;
            }
        LAS float* red = (LAS float*)(F.lds + RING_OFF);
        red[(F.wave * 3 + 0) * 64 + F.lane] = a0; red[(F.wave * 3 + 1) * 64 + F.lane] = a1; red[(F.wave * 3 + 2) * 64 + F.lane] = a2;
        __syncthreads();
        if (F.tid < 192) { const int s = F.tid >> 6, ln = F.tid & 63; float v = padab[l * ADA + 64 * ch + ln];
#pragma unroll
            for (int w = 0; w < 8; ++w) v += red[(w * 3 + s) * 64 + ln];
            mods[(size_t)(l * 3 + s) * ADA + 64 * ch + ln] = v; }
        __syncthreads();
    } else if (bid == 255) {
        float* T = (float*)(F.ws + WS_RPB); const float* prpb = in_ptr(I_RPB);
        for (int i = F.tid; i < 16 * 15 * 64; i += NWAVES * 64) { const int j = i & 63, hd = i >> 6; const int dc = j - 16; T[i] = (dc >= 0 && dc < 31) ? LOG2E * prpb[hd * 31 + dc] : 0.f; }
    }
    LAS float* scr = (LAS float*)(F.lds + RING_OFF + 8192 + F.wave * 12288);
    for (;;) {
        int it = 0;
        if (F.lane == 0) it = (int)__hip_atomic_fetch_add(F.ctl + CW_QUEUE, 1u, RLX_AGENT);
        it = __builtin_amdgcn_readfirstlane(it);
        if (it >= N_CONV_ITEMS) break;
        p0_convert_item(F, it, scr);
    }
}

__device__ __forceinline__ const float* rowp_in(const float* xm, const float* xc, int m) { return m < M_X ? xm + (size_t)m * D : xc + (size_t)(m - M_X) * D; }
__device__ __forceinline__ float* rowp_out(float* xm, float* xc, int m) { return m < M_X ? xm + (size_t)m * D : xc + (size_t)(m - M_X) * D; }

__device__ __forceinline__ void p1_pool_operand(Frame& F) {
    LAS float* NR = (LAS float*)(F.lds + RING_OFF);
    const float* mods = (const float*)(F.ws + WS_MODS);
    bf16* AD = (bf16*)(F.ws + WS_AD);
    const float* px = in_ptr(I_X); const float* pctx = in_ptr(I_CTX); const float* ppre = in_ptr(I_MIXPRE);
    for (int ch = F.vcu; ch < M_T / 16; ch += F.G) {
        const int row0 = 16 * ch;
        const int sq0 = row0 < M_X ? (row0 & ~8191) : (row0 & ~255), sq1 = sq0 + (row0 < M_X ? 8192 : 256);
        const int s = row0 < M_X ? (row0 >> 13) : 2;
        for (int j = F.wave; j < 31; j += NWAVES) {
            const int gr = row0 - 8 + j;
            if (gr >= sq0 && gr < sq1) {
                const f32x4* xr = (const f32x4*)rowp_in(px, pctx, gr) + F.lane;
                f32x4 v[4]; float ss = 0.f;
#pragma unroll
                for (int i = 0; i < 4; ++i) { v[i] = xr[64 * i]; ss += (v[i].x * v[i].x + v[i].y * v[i].y) + (v[i].z * v[i].z + v[i].w * v[i].w); }
                const float rstd = 1.0f / sqrtf(wave_sum(ss) * (1.0f / D) + EPS);
#pragma unroll
                for (int i = 0; i < 4; ++i) *(LAS f32x4*)(NR + j * 1024 + 256 * i + 4 * F.lane) = v[i] * rstd;
            }
        }
        __syncthreads();
        f32x4 gm[4];
#pragma unroll
        for (int i = 0; i < 4; ++i) { const int col = 256 * i + 4 * F.lane; const f32x4 g = *(const f32x4*)(ppre + col), sc = *(const f32x4*)(mods + (size_t)(0 * 3 + s) * ADA + 1 * D + col); gm[i] = g * (sc + 1.0f); }
#pragma unroll
        for (int rr = 0; rr < 2; ++rr) {
            const int t = row0 + F.wave + 8 * rr;
#pragma unroll
            for (int i = 0; i < 4; ++i) {
                const int half = 1 << i; const int lo = (t - half) > sq0 ? (t - half) : sq0, hi = (t + half) < sq1 ? (t + half) : sq1;
                f32x4 S = {0.f, 0.f, 0.f, 0.f};
                for (int r = lo; r < hi; ++r) S += *(LAS f32x4*)(NR + (r - row0 + 8) * 1024 + 256 * i + 4 * F.lane);
                const f32x4 cen = *(LAS f32x4*)(NR + (t - row0 + 8) * 1024 + 256 * i + 4 * F.lane);
                const f32x4 dd = (S * (1.0f / (float)(hi - lo)) - cen) * gm[i];
                v2u o; o.x = pk2(dd.x, dd.y); o.y = pk2(dd.z, dd.w);
                *(v2u*)(AD + (size_t)t * D + 256 * i + 4 * F.lane) = o;
            }
        }
        __syncthreads();
    }
}

struct RowPass {
    const float* Y; const float* colscale; const float* post_g; const float* mods_l; int gate_chunk;
    const float* xin_m; const float* xin_c; float* xout_m; float* xout_c;
    bf16* AD; const float* pre_g; const float* mods_n; int sh_chunk, sc_chunk;
    int nrows;
};
__device__ __forceinline__ void row_pass(Frame& F, const RowPass& P) {
    const int gw = F.vcu * NWAVES + F.wave, NGW = F.G * NWAVES;
    const int rpw = (P.nrows + NGW - 1) / NGW;
    const int m0 = gw * rpw, m1 = (m0 + rpw) < P.nrows ? (m0 + rpw) : P.nrows;
    for (int m = m0; m < m1; ++m) {
        const int s = m < M_X ? (m >> 13) : 2;
        const f32x4* yr = (const f32x4*)(P.Y + (size_t)m * D) + F.lane;
        const f32x4* xr = (const f32x4*)rowp_in(P.xin_m, P.xin_c, m) + F.lane;
        f32x4 y[4], xv[4]; float ss = 0.f;
#pragma unroll
        for (int i = 0; i < 4; ++i) { y[i] = yr[64 * i]; xv[i] = xr[64 * i];
            if (P.colscale) y[i] = y[i] * *((const f32x4*)P.colscale + F.lane + 64 * i);
            ss += (y[i].x * y[i].x + y[i].y * y[i].y) + (y[i].z * y[i].z + y[i].w * y[i].w); }
        const float rstd = 1.0f / sqrtf(wave_sum(ss) * (1.0f / D) + EPS);
        float s2 = 0.f;
        f32x4* xo = (f32x4*)rowp_out(P.xout_m, P.xout_c, m) + F.lane;
#pragma unroll
        for (int i = 0; i < 4; ++i) {
            const f32x4 pg = *((const f32x4*)P.post_g + F.lane + 64 * i), gt = *((const f32x4*)(P.mods_l + (size_t)s * ADA + P.gate_chunk * D) + F.lane + 64 * i);
            xv[i] = xv[i] + gt * (y[i] * rstd * pg);
            xo[64 * i] = xv[i];
            s2 += (xv[i].x * xv[i].x + xv[i].y * xv[i].y) + (xv[i].z * xv[i].z + xv[i].w * xv[i].w);
        }
        if (P.AD) {
            const float rs2 = 1.0f / sqrtf(wave_sum(s2) * (1.0f / D) + EPS);
#pragma unroll
            for (int i = 0; i < 4; ++i) {
                const f32x4 g = *((const f32x4*)P.pre_g + F.lane + 64 * i), sc = *((const f32x4*)(P.mods_n + (size_t)s * ADA + P.sc_chunk * D) + F.lane + 64 * i), sh = *((const f32x4*)(P.mods_n + (size_t)s * ADA + P.sh_chunk * D) + F.lane + 64 * i);
                const f32x4 a = (xv[i] * rs2 * g) * (sc + 1.0f) + sh;
                v2u o; o.x = pk2(a.x, a.y); o.y = pk2(a.z, a.w);
                *(v2u*)(P.AD + (size_t)m * D + 256 * i + 4 * F.lane) = o;
            }
        }
    }
}

__device__ __forceinline__ void p8_vtranspose(Frame& F) {
    const bf16* V = (const bf16*)(F.ws + WS_V); bf16* VT = (bf16*)(F.ws + WS_VT); bf16* VCT = VT + (size_t)2 * 16 * 64 * 8192;
    LAS unsigned char* scr = F.lds + RING_OFF + F.wave * 16384;
    const int gw = F.vcu * NWAVES + F.wave, NGW = F.G * NWAVES;
    for (int it = gw; it < 4096 + 128; it += NGW) {
        int b, h, tb, seqlen, rowbase; bf16* dst;
        if (it < 4096) { b = it >> 11; h = (it >> 7) & 15; tb = it & 127; seqlen = 8192; rowbase = b * 8192; dst = VT + (size_t)(b * 16 + h) * 64 * 8192; }
        else { const int j = it - 4096; b = j >> 6; h = (j >> 2) & 15; tb = j & 3; seqlen = 256; rowbase = M_X + b * 256; dst = VCT + (size_t)(b * 16 + h) * 64 * 256; }
#pragma unroll
        for (int i = 0; i < 8; ++i) { const int row = 8 * i + (F.lane >> 3), chn = F.lane & 7;
            const v4u v = *(const v4u*)(V + (size_t)(rowbase + 64 * tb + row) * D + h * 64 + 8 * chn);
            *(LAS v4u*)(scr + row * 144 + chn * 16) = v; }
        LDS_WAIT(); asm volatile("" ::: "memory");
        const int tp = F.lane & 31, dd = F.lane >> 5;
#pragma unroll 8
        for (int i = 0; i < 32; ++i) { const int d = 2 * i + dd;
            const unsigned lo = *(LAS unsigned short*)(scr + (2 * tp) * 144 + 2 * d), hi = *(LAS unsigned short*)(scr + (2 * tp + 1) * 144 + 2 * d);
            *(unsigned*)(dst + (size_t)d * seqlen + 64 * tb + 2 * tp) = lo | (hi << 16); }
        LDS_WAIT(); asm volatile("" ::: "memory");
    }
}

__device__ __forceinline__ void p9_attention(Frame& F) {
    const bf16* Q = (const bf16*)(F.ws + WS_Q); const bf16* Kb = (const bf16*)(F.ws + WS_K);
    const bf16* VT = (const bf16*)(F.ws + WS_VT); const bf16* VCT = VT + (size_t)2 * 16 * 64 * 8192;
    bf16* O = (bf16*)(F.ws + WS_Q);
    const float* RT = (const float*)(F.ws + WS_RPB);
    LAS unsigned char* R = F.lds + RING_OFF;
    constexpr int VC_OFF = 9 * 64 * 128;
    constexpr int TB_OFF = 104 * 1024;
    { const int h0 = ((F.vcu * 8) >> 6) & 15; for (int i = F.tid; i < 15 * 64; i += NWAVES * 64) *(LAS float*)(R + TB_OFF + 4 * i) = RT[h0 * 15 * 64 + i]; }
    for (int itw = F.vcu * 8; itw < F.vcu * 8 + 8; ++itw) {
        int lane = F.lane; asm volatile("" : "+v"(lane));
        const int l15 = lane & 15, g = lane >> 4;
        const int rp = itw & 63, h = (itw >> 6) & 15, b = itw >> 10;
        const int r0 = 2 * rp, kr0 = (r0 - 4) < 0 ? 0 : ((r0 - 4) > 119 ? 119 : (r0 - 4));
        const int cb = F.wave & 3, r = r0 + (F.wave >> 2);
        const int s0 = (r - 4) < 0 ? 0 : ((r - 4) > 120 ? 120 : (r - 4));
        const int bs = cb == 0 ? 0 : (cb == 1 ? 8 : (cb == 2 ? 24 : 32));
        const int qc = 16 * cb + l15;
        const size_t tq = (size_t)b * 8192 + r * 64 + qc;
#pragma unroll 1
        for (int j = 0; j < 13; ++j) {
            const int pc = F.wave * 13 + j, kk = 8 * pc + (lane >> 3), p = lane & 7, c = p ^ (kk & 7);
            const size_t tok = kk < 576 ? (size_t)b * 8192 + (size_t)(kr0 + (kk >> 6)) * 64 + (kk & 63) : (size_t)M_X + b * 256 + (kk - 576);
            __builtin_amdgcn_global_load_lds((const unsigned*)(Kb + tok * D + h * 64 + 8 * c), (LAS unsigned*)(R + pc * 1024), 16, 0, 0);
        }
        bf16x8 qf[2];
#pragma unroll
        for (int ks = 0; ks < 2; ++ks) qf[ks] = *(const bf16x8*)(Q + tq * D + h * 64 + 32 * ks + 8 * g);
        __syncthreads();
        const int kap = 8 * (l15 >> 2) + (l15 & 3);
        unsigned ka[2][2], kc_[2][2];
#pragma unroll
        for (int tau = 0; tau < 2; ++tau)
#pragma unroll
            for (int ks = 0; ks < 2; ++ks) {
                ka[tau][ks] = (unsigned)((s0 - kr0) * 8192 + bs * 128 + (kap + 4 * tau) * 128 + (((4 * ks + g) ^ ((l15 & 3) + 4 * tau)) << 4)); asm volatile("" : "+v"(ka[tau][ks]));
                kc_[tau][ks] = (unsigned)(576 * 128 + (kap + 4 * tau) * 128 + (((4 * ks + g) ^ ((l15 & 3) + 4 * tau)) << 4)); asm volatile("" : "+v"(kc_[tau][ks])); }
        const int wst = (qc - 8) < 0 ? 0 : ((qc - 8) > 48 ? 48 : (qc - 8));
        float m1 = -3.0e38f, l1 = 0.f, m2 = -3.0e38f, l2 = 0.f;
        bf16x8 pb[16];
        {
            f32x4 sc[8][2];
#pragma unroll
            for (int p = 0; p < 8; ++p) {
#pragma unroll
                for (int tau = 0; tau < 2; ++tau) {
                    const bf16x8 k0 = *(const LAS bf16x8*)(R + ka[tau][0] + p * 8192), k1 = *(const LAS bf16x8*)(R + ka[tau][1] + p * 8192);
                    f32x4 a = {0.f, 0.f, 0.f, 0.f};
                    a = __builtin_amdgcn_mfma_f32_16x16x32_bf16(k0, qf[0], a, 0, 0, 0);
                    a = __builtin_amdgcn_mfma_f32_16x16x32_bf16(k1, qf[1], a, 0, 0, 0);
                    sc[p][tau] = a;
                }
                if (p & 1) __builtin_amdgcn_sched_barrier(0);
            }
#pragma unroll
            for (int p = 0; p < 8; ++p) {
                const int dr = s0 + p - r + 7;
                const LAS float* rt = (const LAS float*)(R + TB_OFF) + dr * 64 + 16 + 15 - qc + bs + 8 * g;
#pragma unroll
                for (int tau = 0; tau < 2; ++tau)
#pragma unroll
                    for (int rho = 0; rho < 4; ++rho) {
                        const int e = 4 * tau + rho, kc = bs + 8 * g + e;
                        const bool valid = (kc >= wst) && (kc < wst + 16);
                        const float bv = rt[e];
                        const float v = valid ? sc[p][tau][rho] + bv : -1.0e30f;
                        sc[p][tau][rho] = v; m1 = fmaxf(m1, v);
                    }
            }
            m1 = fmaxf(m1, __shfl_xor(m1, 16)); m1 = fmaxf(m1, __shfl_xor(m1, 32));
#pragma unroll
            for (int p = 0; p < 8; ++p) {
                float pv[8];
#pragma unroll
                for (int tau = 0; tau < 2; ++tau)
#pragma unroll
                    for (int rho = 0; rho < 4; ++rho) { const float e = __builtin_amdgcn_exp2f(sc[p][tau][rho] - m1); pv[4 * tau + rho] = e; l1 += e; }
                v4u w; w.x = pg8::cvt_pk_bf16(pv[0], pv[1]); w.y = pg8::cvt_pk_bf16(pv[2], pv[3]); w.z = pg8::cvt_pk_bf16(pv[4], pv[5]); w.w = pg8::cvt_pk_bf16(pv[6], pv[7]);
                pb[p] = __builtin_bit_cast(bf16x8, w);
            }
        }
        {
            f32x4 sc[8][2];
#pragma unroll
            for (int p = 0; p < 8; ++p) {
#pragma unroll
                for (int tau = 0; tau < 2; ++tau) {
                    const bf16x8 k0 = *(const LAS bf16x8*)(R + kc_[tau][0] + p * 4096), k1 = *(const LAS bf16x8*)(R + kc_[tau][1] + p * 4096);
                    f32x4 a = {0.f, 0.f, 0.f, 0.f};
                    a = __builtin_amdgcn_mfma_f32_16x16x32_bf16(k0, qf[0], a, 0, 0, 0);
                    a = __builtin_amdgcn_mfma_f32_16x16x32_bf16(k1, qf[1], a, 0, 0, 0);
                    sc[p][tau] = a;
                }
                if (p & 1) __builtin_amdgcn_sched_barrier(0);
            }
            __syncthreads();
#pragma unroll 1
            for (int j = 0; j < 9; ++j) {
                const int pc = F.wave * 9 + j, rr = 8 * pc + (lane >> 3), d = rr & 63, p = lane & 7, c = p ^ (d & 7);
                __builtin_amdgcn_global_load_lds((const unsigned*)(VT + ((size_t)(b * 16 + h) * 64 + d) * 8192 + (size_t)(kr0 + (rr >> 6)) * 64 + 8 * c), (LAS unsigned*)(R + pc * 1024), 16, 0, 0);
            }
#pragma unroll 1
            for (int j = 0; j < 4; ++j) {
                const int pc = F.wave * 4 + j, d = 2 * pc + (lane >> 5), p = lane & 31, c = p ^ (d & 7);
                __builtin_amdgcn_global_load_lds((const unsigned*)(VCT + ((size_t)(b * 16 + h) * 64 + d) * 256 + 8 * c), (LAS unsigned*)(R + VC_OFF + pc * 1024), 16, 0, 0);
            }
#pragma unroll
            for (int p = 0; p < 8; ++p)
#pragma unroll
                for (int tau = 0; tau < 2; ++tau)
#pragma unroll
                    for (int rho = 0; rho < 4; ++rho) m2 = fmaxf(m2, sc[p][tau][rho]);
            m2 = fmaxf(m2, __shfl_xor(m2, 16)); m2 = fmaxf(m2, __shfl_xor(m2, 32));
#pragma unroll
            for (int p = 0; p < 8; ++p) {
                float pv[8];
#pragma unroll
                for (int tau = 0; tau < 2; ++tau)
#pragma unroll
                    for (int rho = 0; rho < 4; ++rho) { const float e = __builtin_amdgcn_exp2f(sc[p][tau][rho] - m2); pv[4 * tau + rho] = e; l2 += e; }
                v4u w; w.x = pg8::cvt_pk_bf16(pv[0], pv[1]); w.y = pg8::cvt_pk_bf16(pv[2], pv[3]); w.z = pg8::cvt_pk_bf16(pv[4], pv[5]); w.w = pg8::cvt_pk_bf16(pv[6], pv[7]);
                pb[8 + p] = __builtin_bit_cast(bf16x8, w);
            }
        }
        l1 += __shfl_xor(l1, 16); l1 += __shfl_xor(l1, 32); l2 += __shfl_xor(l2, 16); l2 += __shfl_xor(l2, 32);
        const float mm = fmaxf(m1, m2), f1 = __builtin_amdgcn_exp2f(m1 - mm), f2 = __builtin_amdgcn_exp2f(m2 - mm);
        const float lsum = l1 * f1 + l2 * f2;
        __syncthreads();
        f32x4 o[4], o2[4];
#pragma unroll
        for (int dt = 0; dt < 4; ++dt) { o[dt] = (f32x4){0.f, 0.f, 0.f, 0.f}; o2[dt] = (f32x4){0.f, 0.f, 0.f, 0.f}; }
        unsigned va = (unsigned)((s0 - kr0) * 8192 + l15 * 128 + ((((bs >> 3) + g) ^ (l15 & 7)) << 4)); asm volatile("" : "+v"(va));
        unsigned vc0 = (unsigned)(VC_OFF + l15 * 512 + ((g ^ (l15 & 7)) << 4)), vc1 = (unsigned)(VC_OFF + l15 * 512 + (((4 + g) ^ (l15 & 7)) << 4)); asm volatile("" : "+v"(vc0), "+v"(vc1));
#pragma unroll
        for (int p = 0; p < 8; ++p) {
#pragma unroll
            for (int dt = 0; dt < 4; ++dt) {
                const bf16x8 vf = *(const LAS bf16x8*)(R + va + p * 8192 + dt * 2048);
                o[dt] = __builtin_amdgcn_mfma_f32_16x16x32_bf16(vf, pb[p], o[dt], 0, 0, 0);
            }
            if (p & 1) __builtin_amdgcn_sched_barrier(0);
        }
#pragma unroll
        for (int p = 0; p < 8; ++p) {
#pragma unroll
            for (int dt = 0; dt < 4; ++dt) {
                const bf16x8 vf = *(const LAS bf16x8*)(R + ((p & 1) ? vc1 : vc0) + dt * 8192 + (p >> 1) * 128);
                o2[dt] = __builtin_amdgcn_mfma_f32_16x16x32_bf16(vf, pb[8 + p], o2[dt], 0, 0, 0);
            }
            if (p & 1) __builtin_amdgcn_sched_barrier(0);
        }
#pragma unroll
        for (int dt = 0; dt < 4; ++dt) o[dt] = o[dt] * f1 + o2[dt] * f2;
        const float inv = 1.0f / lsum;
#pragma unroll
        for (int dt = 0; dt < 4; ++dt) { v2u w; w.x = pk2(o[dt][0] * inv, o[dt][1] * inv); w.y = pk2(o[dt][2] * inv, o[dt][3] * inv);
            *(v2u*)(O + tq * D + h * 64 + 16 * dt + 4 * g) = w; }
        __syncthreads();
    }
}

constexpr int N_PHASES = 15;
__global__ void __launch_bounds__(NWAVES * 64, 2) dit_fwd(Args args) {
    extern __shared__ __attribute__((aligned(16))) unsigned char lds[];
    Frame F;
    F.lds = (LAS unsigned char*)lds;
    F.tid = threadIdx.x; F.lane = F.tid & 63; F.wave = __builtin_amdgcn_readfirstlane(F.tid >> 6);
    F.G = gridDim.x; { const int bx = blockIdx.x; F.vcu = (F.G % 8 == 0) ? (bx % 8) * (F.G / 8) + bx / 8 : bx; }
    unsigned char* ws = args.ws; F.ws = ws; F.out = args.out;
    F.ctl = (gu32*)(ws + WS_CTL);
    volatile LAS unsigned* MISC = (volatile LAS unsigned*)(F.lds + MISC_OFF);
    for (int u = F.tid; u < (LDS_BYTES - LDSCTL_OFF) / 4; u += NWAVES * 64) ((LAS unsigned*)(F.lds + LDSCTL_OFF))[u] = 0u;
    __syncthreads();
    const int lo = args.ph_lo, hi = args.ph_hi;
    XcdBarrier bar; bar.bar = (unsigned*)(F.ctl + CW_BAR); bar.x = 0; bar.st = nullptr;
    if (hi - lo > 1) bar = xcd_barrier_post((unsigned*)(F.ctl + CW_BAR), MISC + 8);
#ifndef PHASE_MASK
#define PHASE_MASK 0x7fff
#endif
#define IN(k) (((PHASE_MASK >> (k)) & 1) && lo <= (k) && (k) < hi)
#ifdef PROBE_A
    unsigned long long tprev = __builtin_amdgcn_s_memrealtime(); float dA = 0.f, dB = 0.f;
#define SEAM(k) do { if (IN(k) && IN((k) + 1)) xcd_barrier(bar); { const unsigned long long tn = __builtin_amdgcn_s_memrealtime(); if ((PROBE_A >> (k)) & 1) dA += (float)(tn - tprev) * 0.01f; if ((PROBE_B >> (k)) & 1) dB += (float)(tn - tprev) * 0.01f; tprev = tn; } } while (0)
#else
#define SEAM(k) do { if (IN(k) && IN((k) + 1)) xcd_barrier(bar); } while (0)
#endif
#define mods ((float*)(ws + WS_MODS))
#define AD ((bf16*)(ws + WS_AD))
#define Y ((float*)(ws + WS_Y))
#define Gb ((bf16*)(ws + WS_G))
#define XC ((float*)(ws + WS_XC))
    const int c = (int)blockIdx.x;

    if (IN(0)) { p0_prologue(F); SEAM(0); }
    if (IN(1)) { p1_pool_operand(F); SEAM(1); }
    if (IN(2)) {
        pg8::Gemm g{AD, (const bf16*)(ws + WS_WPOOL), D, 256, 256, 256};
        pg8::Sched S{F.G, c, 0, 66, 4, 0, 0, 0, 0};
        pg8::EpiF32 E{Y, D};
        pg8::gemm_phase<pg8::EpiF32>(F.lds + RING_OFF, g, S, E);
        SEAM(2);
    }
    if (IN(3)) {
        RowPass P{Y, in_ptr(I_POOLS), in_ptr(I_MIXPOST), mods, 2, in_ptr(I_X), in_ptr(I_CTX), F.out, XC, AD, in_ptr(I_FFNPRE), mods, 3, 4, M_T};
        row_pass(F, P); SEAM(3);
    }
    if (IN(4)) {
        pg8::Gemm g{AD, (const bf16*)(ws + WS_WUP), D, D, D, 0};
        pg8::Sched S{F.G, c, 1, 68, 22, 0, 0, 0, 0};
        pg8::EpiConvAct E{Gb, in_ptr(I_CONVW), in_ptr(I_CONVB)};
        pg8::gemm_phase<pg8::EpiConvAct>(F.lds + RING_OFF, g, S, E);
        SEAM(4);
    }
    if (IN(5)) {
        pg8::Gemm g{Gb, (const bf16*)(ws + WS_WDN), DFF, DFF, DFF, 0};
        pg8::Sched S{F.G, c, 0, 66, 4, 0, 0, 0, 0};
        pg8::EpiF32 E{Y, D};
        pg8::gemm_phase<pg8::EpiF32>(F.lds + RING_OFF, g, S, E);
        SEAM(5);
    }
    if (IN(6)) {
        RowPass P{Y, nullptr, in_ptr(I_FFNPOST), mods, 5, F.out, XC, F.out, XC, AD, in_ptr(I_MIXPRE) + D, mods + 3 * ADA, 0, 1, M_T};
        row_pass(F, P); SEAM(6);
    }
    if (IN(7)) {
        pg8::Gemm g{AD, (const bf16*)(ws + WS_WQKV), D, D, D, 0};
        pg8::Sched S{F.G, c, 0, 64, 12, 2, 8, 64, 4};
        pg8::EpiQKV E{(bf16*)(ws + WS_Q), ((long)WS_K - (long)WS_Q) / 2, ((long)WS_V - (long)WS_K) / 2, QSCALE};
        pg8::gemm_phase<pg8::EpiQKV>(F.lds + RING_OFF, g, S, E);
        SEAM(7);
    }
    if (IN(8)) { p8_vtranspose(F); SEAM(8); }
    if (IN(9)) { p9_attention(F); SEAM(9); }
    if (IN(10)) {
        pg8::Gemm g{(const bf16*)(ws + WS_Q), (const bf16*)(ws + WS_WO), D, D, D, 0};
        pg8::Sched S{F.G, c, 0, 64, 4, 0, 0, 0, 0};
        pg8::EpiF32 E{Y, D};
        pg8::gemm_phase<pg8::EpiF32>(F.lds + RING_OFF, g, S, E);
        SEAM(10);
    }
    if (IN(11)) {
        RowPass P{Y, nullptr, in_ptr(I_MIXPOST) + D, mods + 3 * ADA, 2, F.out, XC, F.out, XC, AD, in_ptr(I_FFNPRE) + D, mods + 3 * ADA, 3, 4, M_X};
        row_pass(F, P); SEAM(11);
    }
    if (IN(12)) {
        pg8::Gemm g{AD, (const bf16*)(ws + WS_WUP) + (size_t)NUP * D, D, D, D, 0};
        pg8::Sched S{F.G, c, 1, 66, 22, 0, 0, 0, 0};
        pg8::EpiConvAct E{Gb, in_ptr(I_CONVW) + 3 * NUP, in_ptr(I_CONVB) + NUP};
        pg8::gemm_phase<pg8::EpiConvAct>(F.lds + RING_OFF, g, S, E);
        SEAM(12);
    }
    if (IN(13)) {
        pg8::Gemm g{Gb, (const bf16*)(ws + WS_WDN) + (size_t)D * DFF, DFF, DFF, DFF, 0};
        pg8::Sched S{F.G, c, 0, 64, 4, 0, 0, 0, 0};
        pg8::EpiF32 E{Y, D};
        pg8::gemm_phase<pg8::EpiF32>(F.lds + RING_OFF, g, S, E);
        SEAM(13);
    }
    if (IN(14)) {
        RowPass P{Y, nullptr, in_ptr(I_FFNPOST) + D, mods + 3 * ADA, 5, F.out, XC, F.out, XC, nullptr, nullptr, nullptr, 0, 0, M_X};
        row_pass(F, P);
    }
#ifdef PROBE_A
    { const unsigned long long tn = __builtin_amdgcn_s_memrealtime(); if ((PROBE_A >> 14) & 1) dA += (float)(tn - tprev) * 0.01f; if ((PROBE_B >> 14) & 1) dB += (float)(tn - tprev) * 0.01f;
      if (blockIdx.x == 0) {
          const float extra_us = 10.f * dA + 8000.f * floorf(dB * 0.1f + 0.5f);
          const unsigned long long ticks = (unsigned long long)(extra_us * 100.f);
          while (__builtin_amdgcn_s_memrealtime() - tn < ticks) __builtin_amdgcn_s_sleep(20);
      } }
#endif
#undef IN
#undef SEAM
#undef mods
#undef AD
#undef Y
#undef Gb
#undef XC
}

extern "C" void kernel_launch(void* const* d_in, const int* in_sizes, int n_in, void* d_out, int out_size, void* d_ws, size_t ws_size, hipStream_t stream) {
    static int grid = 0;
    if (grid == 0) {
        if (n_in != 19 || in_sizes[0] != M_X * D || out_size != M_X * D || ws_size < WS_END) { fprintf(stderr, "kernel_launch: unexpected shapes (n_in %d, in0 %d, out %d, ws %zu)\n", n_in, n_in > 0 ? in_sizes[0] : -1, out_size, ws_size); grid = -1; return; }
        int dev = 0, cus = 0, per_cu = 0;
        if (hipGetDevice(&dev) != hipSuccess || hipDeviceGetAttribute(&cus, hipDeviceAttributeMultiprocessorCount, dev) != hipSuccess) { grid = -1; return; }
        if (hipFuncSetAttribute((const void*)dit_fwd, hipFuncAttributeMaxDynamicSharedMemorySize, LDS_BYTES) != hipSuccess) { fprintf(stderr, "kernel_launch: hipFuncSetAttribute failed\n"); grid = -1; return; }
        if (hipOccupancyMaxActiveBlocksPerMultiprocessor(&per_cu, (const void*)dit_fwd, NWAVES * 64, LDS_BYTES) != hipSuccess || per_cu < 1) { fprintf(stderr, "kernel_launch: occupancy query reports %d blocks per CU\n", per_cu); }
        (void)hipGetLastError();
        grid = cus;
    }
    if (grid < 0) return;
    if (hipMemsetAsync((char*)d_ws + WS_CTL, 0, CTL_ZERO_BYTES, stream) != hipSuccess) { fprintf(stderr, "kernel_launch: memset failed\n"); return; }
    Args a{};
    for (int i = 0; i < 19; ++i) a.in[i] = (const float*)d_in[i];
    a.out = (float*)d_out; a.ws = (unsigned char*)d_ws;
#if MK_N_LAUNCHES == 1
    a.ph_lo = 0; a.ph_hi = N_PHASES;
    hipLaunchKernelGGL(dit_fwd, dim3(grid), dim3(NWAVES * 64), LDS_BYTES, stream, a);
#else
    for (int p = 0; p < N_PHASES; ++p) { a.ph_lo = p; a.ph_hi = p + 1; hipLaunchKernelGGL(dit_fwd, dim3(grid), dim3(NWAVES * 64), LDS_BYTES, stream, a); }
#endif
    const hipError_t le = hipPeekAtLastError();
    if (le != hipSuccess) fprintf(stderr, "kernel_launch: launch failed: %s (grid %d)\n", hipGetErrorName(le), grid);
}
```

```cpp
#include <hip/hip_runtime.h>
#include <cstdio>
#include <cstdint>

#ifndef MK_N_LAUNCHES
#define MK_N_LAUNCHES 1
#endif

constexpr int D = 1024, SEQ = 8192, M_X = 16384, CTXL = 256, M_T = 16896;
constexpr int DFF = 2816, NUP = 5632, NHEAD = 16, ADA = 6144;
constexpr float EPS = 1e-6f;
constexpr float LOG2E = 1.4426950408889634f;
constexpr float QSCALE = 0.125f * LOG2E;

constexpr size_t MiB = 1u << 20;
constexpr size_t WS_CTL = 0, CTL_ZERO_BYTES = 1 * MiB;
constexpr size_t WS_MODS = 1 * MiB;
constexpr size_t WS_RPB = 1 * MiB + 256 * 1024;
constexpr size_t WS_XC = 2 * MiB;
constexpr size_t WS_WPOOL = 4 * MiB;
constexpr size_t WS_WQKV = 5 * MiB;
constexpr size_t WS_WO = 11 * MiB;
constexpr size_t WS_WUP = 13 * MiB;
constexpr size_t WS_WDN = 35 * MiB;
constexpr size_t WS_AD = 46 * MiB;
constexpr size_t WS_Y = 79 * MiB;
constexpr size_t WS_G = 145 * MiB;
constexpr size_t WS_Q = WS_G, WS_K = WS_G + 33 * MiB, WS_V = WS_Y, WS_VT = WS_Y + 33 * MiB;
constexpr size_t WS_SLAB = 236 * MiB;
constexpr size_t WS_END = 256 * MiB;
static_assert(WS_G + (size_t)M_T * DFF * 2 <= WS_SLAB && WS_SLAB + 10 * 2 * MiB <= WS_END, "workspace map");
static_assert(WS_K + 33 * MiB <= WS_SLAB && WS_VT + 33 * MiB <= WS_G, "overlays");

constexpr int CW_TMO = 0, CW_QUEUE = 64, CW_BAR = 4096;

namespace pg8 {
#define PG8_LAS __attribute__((address_space(3)))
typedef unsigned short bf16_t;
typedef short bf16x8 __attribute__((ext_vector_type(8)));
typedef float f32x4 __attribute__((ext_vector_type(4)));
typedef unsigned u32x4 __attribute__((ext_vector_type(4)));
typedef unsigned u32x2 __attribute__((ext_vector_type(2)));
constexpr int BM = 256, BK = 64, HALF = 128, HTB = HALF * BK * 2, STAGE_BYTES = 8 * HTB, NXCD = 8, WGM = 8;

__host__ __device__ __forceinline__ int lds_byte(int r, int c) { const int st = (r >> 4) * 2 + (c >> 5), rr = r & 15, cc = c & 31, ob = rr * 64 + cc * 2; return st * 1024 + (ob ^ (((ob >> 9) & 1) << 5)); }
__host__ __device__ __forceinline__ void stage_rc(int b, int& R, int& C) { const int st = b / 1024, sb = b % 1024, swz = sb ^ (((sb >> 9) & 1) << 5); R = (st >> 1) * 16 + swz / 64; C = (st & 1) * 32 + (swz % 64) / 2; }
__host__ __device__ __forceinline__ int perm32(int rho) { const int n = rho >> 4, i = rho & 15; return 8 * (i >> 2) + 4 * n + (i & 3); }

struct Unit { int arow, pn, flags, kt0, nkt, sl; };
struct Gemm { const bf16_t* A; const bf16_t* Bt; int lda, ldb, K, a_pn_off; };

struct Sched {
    int G, c, mode;
    int nM1, nN1, nM2, nN2, rt2, pn2;
    int nkt, nS2;
    __device__ __forceinline__ static void swz(int L, int nM, int nN, int& tm, int& pn) {
        const int nwg = nM * nN; int wgid = L; { const int q = nwg / NXCD, r = nwg % NXCD, xcd = wgid % NXCD, off = wgid / NXCD; wgid = (xcd < r ? xcd * (q + 1) : r * (q + 1) + (xcd - r) * q) + off; }
        const int nig = WGM * nN, gid = wgid / nig, fm = gid * WGM, gsz = (nM - fm) < WGM ? (nM - fm) : WGM;
        tm = fm + ((wgid % nig) % gsz); pn = (wgid % nig) / gsz;
    }
    __device__ __forceinline__ bool next(int i, Unit& u) const {
        const long L = (long)i * G + c; const int n1 = nM1 * nN1, n2 = nM2 * nN2; int tm, pn;
        if (L < n1) {
            swz((int)L, nM1, nN1, tm, pn); u.pn = pn; u.kt0 = 0; u.nkt = nkt; u.sl = 0;
            if (mode == 0) { u.arow = 256 * tm; u.flags = 0; }
            else if (tm < 66) { const int sq = tm / 33, k = tm - 33 * sq; const int s = 254 * k < 7936 ? 254 * k : 7936; u.arow = sq * 8192 + s; u.flags = (k == 0 ? 1 : 0) | (k == 32 ? 2 : 0); }
            else { u.arow = 16384 + 256 * (tm - 66); u.flags = 3; }
            return true;
        }
        if (L < n1 + n2 * nS2) { const int L2 = (int)(L - n1), j = L2 / n2; swz(L2 - j * n2, nM2, nN2, tm, pn); u.arow = 256 * (rt2 + tm); u.pn = pn2 + pn;
            const int per = nkt / nS2; u.kt0 = j * per; u.nkt = per; u.sl = j; u.flags = nS2 > 1 ? 4 : 0; return true; }
        return false;
    }
};

__device__ __forceinline__ unsigned cvt_pk_bf16(float lo, float hi) { unsigned r; asm volatile("v_cvt_pk_bf16_f32 %0, %1, %2" : "=v"(r) : "v"(lo), "v"(hi)); return r; }

struct EpiF32 {
    static constexpr bool PERM = false, USES_LDS = false;
    float* C; int ldc; float* slab0; float* slab1; int slab_row0;
    __device__ __forceinline__ void operator()(const f32x4 (&acc)[2][2][4][2], const Unit& u, int wr, int wc, int fr, int fq) const {
        const bool sk = (u.flags & 4) != 0;
        float* Cb = sk ? (u.sl ? slab1 + (size_t)(u.sl - 1) * 512 * ldc : slab0) : C;
        const int row0 = u.arow - (sk ? slab_row0 : 0) + wr * 64 + fr, col0 = u.pn * BM + wc * 32 + 4 * fq;
#pragma unroll
        for (int ai = 0; ai < 2; ++ai)
#pragma unroll
            for (int m = 0; m < 4; ++m) { float* rowp = Cb + (size_t)(row0 + ai * HALF + m * 16) * ldc + col0;
#pragma unroll
                for (int bj = 0; bj < 2; ++bj)
#pragma unroll
                    for (int n = 0; n < 2; ++n) *(f32x4*)(rowp + bj * HALF + n * 16) = acc[ai][bj][m][n]; }
    }
};
struct EpiQKV {
    static constexpr bool PERM = true, USES_LDS = false;
    bf16_t* Oq; long dk, dv; float scale0;
    __device__ __forceinline__ void operator()(const f32x4 (&acc)[2][2][4][2], const Unit& u, int wr, int wc, int fr, int fq) const {
        const int t = u.pn >> 2; bf16_t* base = Oq + (t >= 1 ? dk : 0l) + (t >= 2 ? dv : 0l); const float sc = t == 0 ? scale0 : 1.f;
        const int row0 = u.arow + wr * 64 + fr, col0 = (u.pn & 3) * BM + wc * 32 + 8 * fq;
#pragma unroll
        for (int ai = 0; ai < 2; ++ai)
#pragma unroll
            for (int m = 0; m < 4; ++m) { bf16_t* rowp = base + (size_t)(row0 + ai * HALF + m * 16) * 1024 + col0;
#pragma unroll
                for (int bj = 0; bj < 2; ++bj) { const f32x4 v0 = acc[ai][bj][m][0] * sc, v1 = acc[ai][bj][m][1] * sc;
                    u32x4 w; w.x = cvt_pk_bf16(v0[0], v0[1]); w.y = cvt_pk_bf16(v0[2], v0[3]); w.z = cvt_pk_bf16(v1[0], v1[1]); w.w = cvt_pk_bf16(v1[2], v1[3]);
                    *(u32x4*)(rowp + bj * HALF) = w; } }
    }
};
__device__ __forceinline__ float dpp_up(float v) { return __builtin_bit_cast(float, __builtin_amdgcn_update_dpp(0, __builtin_bit_cast(int, v), 0x121, 0xf, 0xf, false)); }
__device__ __forceinline__ float dpp_dn(float v) { return __builtin_bit_cast(float, __builtin_amdgcn_update_dpp(0, __builtin_bit_cast(int, v), 0x12F, 0xf, 0xf, false)); }
__device__ __forceinline__ float gelu_tanh(float v) {
    const float z = v * (1.5957691216f + 0.0713548163f * v * v);
    const float e = __builtin_amdgcn_exp2f(-LOG2E * z);
    return v * __builtin_amdgcn_rcpf(1.0f + e);
}
struct EpiConvAct {
    static constexpr bool PERM = true, USES_LDS = true;
    bf16_t* Gout; const float* cw; const float* cb;
    __device__ __forceinline__ void run(const f32x4 (&acc)[2][2][4][2], const Unit& u, int wr, int wc, int fr, int fq, PG8_LAS unsigned char* ldsx) const {
        PG8_LAS float* E = (PG8_LAS float*)ldsx;
        const int cih = wc * 32 + 8 * fq;
#pragma unroll
        for (int ai = 0; ai < 2; ++ai) { const int blk = 2 * ai + wr;
#pragma unroll
            for (int bj = 0; bj < 2; ++bj)
#pragma unroll
                for (int n = 0; n < 2; ++n) {
                    if (fr == 0)  *(PG8_LAS f32x4*)(E + (blk * 2 + 0) * 256 + bj * 128 + cih + 4 * n) = acc[ai][bj][0][n];
                    if (fr == 15) *(PG8_LAS f32x4*)(E + (blk * 2 + 1) * 256 + bj * 128 + cih + 4 * n) = acc[ai][bj][3][n];
                } }
        asm volatile("s_waitcnt lgkmcnt(0)" ::: "memory"); __builtin_amdgcn_s_barrier(); asm volatile("" ::: "memory");
        const int gcol0 = u.pn * 128 + cih;
        const bool first = (u.flags & 1) != 0, last = (u.flags & 2) != 0;
        u32x2 keep[2][4];
#pragma unroll
        for (int n = 0; n < 2; ++n) {
            const int gc = gcol0 + 4 * n;
            const f32x4 wg0 = *(const f32x4*)(cw + gc), wg1 = *(const f32x4*)(cw + NUP + gc), wg2 = *(const f32x4*)(cw + 2 * NUP + gc), bg = *(const f32x4*)(cb + gc);
            const f32x4 wv0 = *(const f32x4*)(cw + DFF + gc), wv1 = *(const f32x4*)(cw + NUP + DFF + gc), wv2 = *(const f32x4*)(cw + 2 * NUP + DFF + gc), bv = *(const f32x4*)(cb + DFF + gc);
#pragma unroll
            for (int ai = 0; ai < 2; ++ai) { const int blk = 2 * ai + wr;
                f32x4 upg = {0.f, 0.f, 0.f, 0.f}, upv = upg, dng = upg, dnv = upg;
                if (blk > 0) { upg = *(PG8_LAS f32x4*)(E + ((blk - 1) * 2 + 1) * 256 + cih + 4 * n); upv = *(PG8_LAS f32x4*)(E + ((blk - 1) * 2 + 1) * 256 + 128 + cih + 4 * n); }
                if (blk < 3) { dng = *(PG8_LAS f32x4*)(E + ((blk + 1) * 2 + 0) * 256 + cih + 4 * n); dnv = *(PG8_LAS f32x4*)(E + ((blk + 1) * 2 + 0) * 256 + 128 + cih + 4 * n); }
#pragma unroll
                for (int m = 0; m < 4; ++m) {
                    const f32x4 cg = acc[ai][0][m][n], cv = acc[ai][1][m][n];
                    float og[4];
#pragma unroll
                    for (int e = 0; e < 4; ++e) {
                        float ug = dpp_up(cg[e]), uv = dpp_up(cv[e]), dg = dpp_dn(cg[e]), dv = dpp_dn(cv[e]);
                        const float pg = m > 0 ? dpp_up(acc[ai][0][m > 0 ? m - 1 : 0][n][e]) : upg[e], pv = m > 0 ? dpp_up(acc[ai][1][m > 0 ? m - 1 : 0][n][e]) : upv[e];
                        const float ng = m < 3 ? dpp_dn(acc[ai][0][m < 3 ? m + 1 : 3][n][e]) : dng[e], nv = m < 3 ? dpp_dn(acc[ai][1][m < 3 ? m + 1 : 3][n][e]) : dnv[e];
                        if (fr == 0) { ug = pg; uv = pv; }
                        if (fr == 15) { dg = ng; dv = nv; }
                        const float hg = bg[e] + wg0[e] * ug + wg1[e] * cg[e] + wg2[e] * dg;
                        const float hv = bv[e] + wv0[e] * uv + wv1[e] * cv[e] + wv2[e] * dv;
                        og[e] = gelu_tanh(hg) * hv;
                    }
                    u32x2 w; w.x = cvt_pk_bf16(og[0], og[1]); w.y = cvt_pk_bf16(og[2], og[3]);
                    if (n == 0) keep[ai][m] = w;
                    else {
                        const int tr = 128 * ai + 64 * wr + 16 * m + fr;
                        const bool ok = (tr >= 1 && tr <= 254) || (tr == 0 && first) || (tr == 255 && last);
                        if (ok) { u32x4 o; o.x = keep[ai][m].x; o.y = keep[ai][m].y; o.z = w.x; o.w = w.y; *(u32x4*)(Gout + (size_t)(u.arow + tr) * DFF + gcol0) = o; }
                    }
                }
            }
        }
    }
};

template <class Epi, bool ALIGN_EPI = true>
__device__ __forceinline__ void gemm_phase(PG8_LAS unsigned char* lds, const Gemm g, const Sched& S, const Epi& E) {
    const int tid = threadIdx.x, wid = __builtin_amdgcn_readfirstlane(tid >> 6), lane = tid & 63, wr = wid >> 2, wc = wid & 3, fr = lane & 15, fq = lane >> 4;
    unsigned voffA[2], voffB[2];
#pragma unroll
    for (int i = 0; i < 2; ++i) { int R, C; stage_rc(tid * 16 + i * 8192, R, C); const int Rb = Epi::PERM ? ((R & ~31) + perm32(R & 31)) : R;
        voffA[i] = (unsigned)(R * g.lda + C) * 2u; voffB[i] = (unsigned)(Rb * g.ldb + C) * 2u; }
    const size_t kstep = (size_t)(BK * 2);
    const size_t hstepA = (size_t)HALF * g.lda * 2, hstepB = (size_t)HALF * g.ldb * 2;
    const unsigned ldsw = (unsigned)wid * 1024u;
    const int aoff = lds_byte(wr * 64 + fr, fq * 8), boff = lds_byte(wc * 32 + fr, fq * 8);
#define PG8_SA(b, h) (((b) * 2 + (h)) * HTB)
#define PG8_SB(b, h) ((4 + (b) * 2 + (h)) * HTB)
#define PG8_STAGE(bufoff, gbase, voff) do { _Pragma("unroll") for (int _i = 0; _i < 2; ++_i) \
        __builtin_amdgcn_global_load_lds((const unsigned*)((const char*)(gbase) + (voff)[_i]), (PG8_LAS unsigned*)(lds + (bufoff) + ldsw + _i * 8192), 16, 0, 0); } while (0)
#define PG8_LDA(dst, b, h) do { _Pragma("unroll") for (int m = 0; m < 4; ++m) _Pragma("unroll") for (int k = 0; k < 2; ++k) dst[m][k] = *(const PG8_LAS bf16x8*)(lds + PG8_SA(b, h) + aoff + m * 2048 + k * 1024); } while (0)
#define PG8_LDB(dst, b, h) do { _Pragma("unroll") for (int n = 0; n < 2; ++n) _Pragma("unroll") for (int k = 0; k < 2; ++k) dst[n][k] = *(const PG8_LAS bf16x8*)(lds + PG8_SB(b, h) + boff + n * 2048 + k * 1024); } while (0)
#define PG8_MMA(ai, bj, At, Bt) do { __builtin_amdgcn_s_setprio(1); _Pragma("unroll") for (int m = 0; m < 4; ++m) _Pragma("unroll") for (int n = 0; n < 2; ++n) _Pragma("unroll") for (int k = 0; k < 2; ++k) \
        acc[ai][bj][m][n] = __builtin_amdgcn_mfma_f32_16x16x32_bf16(Bt[n][k], At[m][k], acc[ai][bj][m][n], 0, 0, 0); __builtin_amdgcn_s_setprio(0); } while (0)
#define PG8_WAIT_V(n) asm volatile("s_waitcnt vmcnt(" #n ")" ::: "memory")
#define PG8_WAIT_L(n) asm volatile("s_waitcnt lgkmcnt(" #n ")" ::: "memory")
#define PG8_BAR __builtin_amdgcn_s_barrier()
#define PG8_SCHED __builtin_amdgcn_sched_barrier(0)
    Unit cur, nxt; int ui = 0;
    if (!S.next(0, cur)) return;
    f32x4 acc[2][2][4][2];
#pragma unroll
    for (int a = 0; a < 2; ++a)
#pragma unroll
        for (int b = 0; b < 2; ++b)
#pragma unroll
            for (int m = 0; m < 4; ++m)
#pragma unroll
                for (int n = 0; n < 2; ++n) acc[a][b][m][n] = (f32x4){0.f, 0.f, 0.f, 0.f};
    bf16x8 At[4][2], B0[2][2], B1[2][2];
    const char* cA = (const char*)g.A + ((size_t)cur.arow * g.lda + (size_t)cur.pn * g.a_pn_off + (size_t)cur.kt0 * BK) * 2; const char* cB = (const char*)g.Bt + ((size_t)cur.pn * BM * g.ldb + (size_t)cur.kt0 * BK) * 2;
    PG8_STAGE(PG8_SB(0, 0), cB, voffB); PG8_STAGE(PG8_SB(0, 1), cB + hstepB, voffB); PG8_STAGE(PG8_SA(0, 0), cA, voffA); PG8_STAGE(PG8_SA(0, 1), cA + hstepA, voffA);
    if (wr == 1) PG8_BAR;
    PG8_WAIT_V(2); PG8_BAR;
    PG8_STAGE(PG8_SB(1, 0), cB + kstep, voffB); PG8_STAGE(PG8_SA(1, 0), cA + kstep, voffA); PG8_STAGE(PG8_SB(1, 1), cB + hstepB + kstep, voffB);
    PG8_WAIT_V(6); PG8_BAR;
    for (;;) {
        const bool has_next = S.next(ui + 1, nxt);
        const char* nA = has_next ? (const char*)g.A + ((size_t)nxt.arow * g.lda + (size_t)nxt.pn * g.a_pn_off + (size_t)nxt.kt0 * BK) * 2 : cA; const char* nB = has_next ? (const char*)g.Bt + ((size_t)nxt.pn * BM * g.ldb + (size_t)nxt.kt0 * BK) * 2 : cB;
        const int nt = cur.nkt;
        for (int t = 0; t < nt; t += 2) {
            const bool last = (t == nt - 2);
            const char* a1 = cA + (size_t)(t + 1) * kstep;
            const char* a2 = last ? nA : cA + (size_t)(t + 2) * kstep; const char* b2 = last ? nB : cB + (size_t)(t + 2) * kstep;
            const char* a3 = a2 + kstep; const char* b3 = b2 + kstep;
            PG8_LDB(B0, 0, 0); PG8_LDB(B1, 0, 1); PG8_SCHED; PG8_LDA(At, 0, 0); PG8_STAGE(PG8_SA(1, 1), a1 + hstepA, voffA);
            PG8_WAIT_V(8); PG8_WAIT_L(0); PG8_BAR; PG8_MMA(0, 0, At, B0); PG8_MMA(0, 1, At, B1); PG8_BAR; PG8_SCHED;
            PG8_LDA(At, 0, 1); PG8_STAGE(PG8_SB(0, 0), b2, voffB); PG8_STAGE(PG8_SB(0, 1), b2 + hstepB, voffB); PG8_STAGE(PG8_SA(0, 0), a2, voffA);
            PG8_WAIT_V(8); PG8_WAIT_L(0); PG8_BAR; PG8_MMA(1, 0, At, B0); PG8_MMA(1, 1, At, B1); PG8_BAR; PG8_SCHED;
            PG8_LDB(B0, 1, 0); PG8_LDB(B1, 1, 1); PG8_SCHED; PG8_LDA(At, 1, 0); PG8_STAGE(PG8_SA(0, 1), a2 + hstepA, voffA);
            PG8_WAIT_V(8); PG8_WAIT_L(0); PG8_BAR; PG8_MMA(0, 0, At, B0); PG8_MMA(0, 1, At, B1); PG8_BAR; PG8_SCHED;
            PG8_LDA(At, 1, 1); PG8_STAGE(PG8_SB(1, 0), b3, voffB); PG8_STAGE(PG8_SB(1, 1), b3 + hstepB, voffB); PG8_STAGE(PG8_SA(1, 0), a3, voffA);
            PG8_WAIT_V(8); PG8_WAIT_L(0); PG8_BAR; PG8_MMA(1, 0, At, B0); PG8_MMA(1, 1, At, B1); PG8_BAR; PG8_SCHED;
        }
        if constexpr (ALIGN_EPI) { if (wr == 0) PG8_BAR; }
        if constexpr (Epi::USES_LDS) E.run(acc, cur, wr, wc, fr, fq, lds + STAGE_BYTES); else E(acc, cur, wr, wc, fr, fq);
        if (!has_next) break;
#pragma unroll
        for (int a = 0; a < 2; ++a)
#pragma unroll
            for (int b = 0; b < 2; ++b)
#pragma unroll
                for (int m = 0; m < 4; ++m)
#pragma unroll
                    for (int n = 0; n < 2; ++n) acc[a][b][m][n] = (f32x4){0.f, 0.f, 0.f, 0.f};
        cur = nxt; cA = nA; cB = nB; ++ui;
        if constexpr (ALIGN_EPI) { if (wr == 1) PG8_BAR; }
    }
    PG8_WAIT_V(0);
    if constexpr (!ALIGN_EPI) { if (wr == 0) PG8_BAR; }
    PG8_BAR;
#undef PG8_SA
#undef PG8_SB
#undef PG8_STAGE
#undef PG8_LDA
#undef PG8_LDB
#undef PG8_MMA
#undef PG8_WAIT_V
#undef PG8_WAIT_L
#undef PG8_BAR
#undef PG8_SCHED
}
}

constexpr int RING_OFF = 0, RING_BYTES = 131072;
constexpr int EDGE_OFF = RING_BYTES, EDGE_BYTES = 8192;
constexpr int LDSCTL_OFF = EDGE_OFF + EDGE_BYTES, MISC_OFF = LDSCTL_OFF + 320;
constexpr int LDS_BYTES = 147456;
static_assert(MISC_OFF + 128 <= LDS_BYTES, "LDS map");
constexpr int NWAVES = 8;

#define GAS __attribute__((address_space(1)))
#define LAS __attribute__((address_space(3)))
typedef unsigned short bf16;
typedef unsigned v4u __attribute__((ext_vector_type(4)));
typedef unsigned v2u __attribute__((ext_vector_type(2)));
typedef float f32x4 __attribute__((ext_vector_type(4)));
typedef short bf16x8 __attribute__((ext_vector_type(8)));
typedef GAS unsigned gu32;
#define RLX_AGENT __ATOMIC_RELAXED, __HIP_MEMORY_SCOPE_AGENT
#define LDS_WAIT() asm volatile("s_waitcnt lgkmcnt(0)" ::: "memory")
#define VM_WAIT() asm volatile("s_waitcnt vmcnt(0)" ::: "memory")
__device__ __forceinline__ unsigned f2bf(float f) { unsigned u = __builtin_bit_cast(unsigned, f); return (u + 0x7fffu + ((u >> 16) & 1u)) >> 16; }
__device__ __forceinline__ unsigned pk2(float lo, float hi) { return f2bf(lo) | (f2bf(hi) << 16); }

#define XB_TMO      128
#define XB_XCNT(j)  (256  + 64 * (j))
#define XB_XSUB(j)  (1280 + 64 * (j))
#define XB_XGEN(j)  (2304 + 64 * (j))
#define XB_TOP      3328
#define XB_TOPGEN   3392
#define XCD_BAR_WORDS 3456
#define XB_SPIN_CAP (1u << 18)
__device__ __forceinline__ unsigned xb_ld(unsigned* p)              { return __hip_atomic_load(p, __ATOMIC_RELAXED, __HIP_MEMORY_SCOPE_AGENT); }
__device__ __forceinline__ unsigned xb_add(unsigned* p, unsigned v) { return __hip_atomic_fetch_add(p, v, __ATOMIC_RELAXED, __HIP_MEMORY_SCOPE_AGENT); }
__device__ __forceinline__ unsigned xb_xcc_id() { return (unsigned)__builtin_amdgcn_s_getreg((3 << 11) | 20) & 0xFu; }
#define XB_SPIN(cond, bar) do { unsigned _sp = 0; while (cond) { __builtin_amdgcn_s_sleep(1); \
    if ((++_sp & 255u) == 0u) { if (xb_ld(&(bar)[XB_TMO])) break; if (_sp > XB_SPIN_CAP) { atomicAdd(&(bar)[XB_TMO], 1u); break; } } } } while (0)
struct XcdBarrier { unsigned* bar; unsigned x; volatile LAS unsigned* st; };
__device__ __forceinline__ XcdBarrier xcd_barrier_post(unsigned* bar, volatile LAS unsigned* st) {
    XcdBarrier b; b.bar = bar; b.x = xb_xcc_id(); b.st = st;
    if (threadIdx.x == 0) (void)xb_add(&bar[XB_XCNT(b.x)], 1u);
    return b;
}
__device__ __forceinline__ void xcd_barrier_complete(unsigned* bar, unsigned x, unsigned& nloc, unsigned& nx) {
    const unsigned G = gridDim.x * gridDim.y * gridDim.z;
    unsigned sum, cnt, mine, sp = 0u;
    for (;;) {
        sum = 0u; cnt = 0u; mine = 0u;
#pragma unroll
        for (unsigned j = 0; j < 16; ++j) { const unsigned c = xb_ld(&bar[XB_XCNT(j)]); sum += c; cnt += (c > 0u) ? 1u : 0u; mine = (j == x) ? c : mine; }
        if (sum == G) break;
        __builtin_amdgcn_s_sleep(1);
        if ((++sp & 255u) == 0u) { if (xb_ld(&bar[XB_TMO])) break; if (sp > XB_SPIN_CAP) { atomicAdd(&bar[XB_TMO], 1u); break; } }
    }
    nloc = mine > 0u ? mine : 1u; nx = cnt > 0u ? cnt : 1u;
}
__device__ __forceinline__ void xcd_barrier(const XcdBarrier& b) {
    asm volatile("s_waitcnt vmcnt(0)" ::: "memory");
    __syncthreads();
    if (threadIdx.x == 0) {
        unsigned* bar = b.bar;
        __builtin_amdgcn_s_waitcnt(0);
        unsigned nloc = b.st[0], nx = b.st[1];
        if (nloc == 0u) { xcd_barrier_complete(bar, b.x, nloc, nx); b.st[0] = nloc; b.st[1] = nx; }
        const unsigned old = xb_add(&bar[XB_XSUB(b.x)], 1u);
        const unsigned gen = old / nloc;
        if (old + 1u == (gen + 1u) * nloc) {
            __builtin_amdgcn_fence(__ATOMIC_RELEASE, "agent");
            asm volatile("s_waitcnt vmcnt(0)" ::: "memory");
            const unsigned og = xb_add(&bar[XB_TOP], 1u);
            const unsigned tg = og / nx;
            if (og + 1u == (tg + 1u) * nx) xb_add(&bar[XB_TOPGEN], 1u);
            else XB_SPIN(xb_ld(&bar[XB_TOPGEN]) == tg, bar);
            __builtin_amdgcn_fence(__ATOMIC_ACQUIRE, "agent");
            xb_add(&bar[XB_XGEN(b.x)], 1u);
            asm volatile("s_waitcnt vmcnt(0)" ::: "memory");
        } else {
            XB_SPIN(xb_ld(&bar[XB_XGEN(b.x)]) == gen, bar);
            __builtin_amdgcn_fence(__ATOMIC_ACQUIRE, "agent");
            asm volatile("s_waitcnt vmcnt(0)" ::: "memory");
        }
    }
    __syncthreads();
}

struct Args { const float* in[19]; float* out; unsigned char* ws; int ph_lo, ph_hi; };
struct Frame {
    LAS unsigned char* lds;
    gu32* ctl;
    int tid, lane, wave, vcu, G;
    float* out; unsigned char* ws;
};
typedef __attribute__((address_space(4))) const char* kernarg_cptr;
__device__ __forceinline__ const float* in_ptr(int i) { kernarg_cptr kp = (kernarg_cptr)__builtin_amdgcn_kernarg_segment_ptr(); asm volatile("" : "+s"(kp)); return *(const float* __attribute__((address_space(4))) const*)(kp + 8 * i); }
enum { I_X = 0, I_C, I_CTX, I_CCTX, I_ADAW, I_ADAB, I_MIXPRE, I_MIXPOST, I_FFNPRE, I_FFNPOST, I_POOLW, I_POOLS, I_WQKV, I_WO, I_RPB, I_WUP, I_CONVW, I_CONVB, I_WDOWN };
__device__ __forceinline__ float wave_sum(float v) {
#pragma unroll
    for (int o = 1; o < 64; o <<= 1) v += __shfl_xor(v, o);
    return v;
}
__device__ __forceinline__ float silu(float v) { return v / (1.0f + __expf(-v)); }

__device__ __forceinline__ void p0_transpose_item(const float* W, int ldw, int k0, int n0, bf16* WT, int ldwt, int dst_row0, LAS float* scr, int lane) {
#pragma unroll 8
    for (int i = 0; i < 32; ++i) { const int kk = 2 * i + (lane >> 5); scr[kk * 33 + (lane & 31)] = W[(size_t)(k0 + kk) * ldw + n0 + (lane & 31)]; }
    LDS_WAIT(); asm volatile("" ::: "memory");
    const int c = lane & 7;
#pragma unroll
    for (int j = 0; j < 4; ++j) { const int n = (lane >> 3) + 8 * j; const LAS float* s = scr + (8 * c) * 33 + n;
        v4u o; o.x = pk2(s[0 * 33], s[1 * 33]); o.y = pk2(s[2 * 33], s[3 * 33]); o.z = pk2(s[4 * 33], s[5 * 33]); o.w = pk2(s[6 * 33], s[7 * 33]);
        *(GAS v4u*)(WT + (size_t)(dst_row0 + n) * ldwt + k0 + 8 * c) = o; }
    LDS_WAIT(); asm volatile("" ::: "memory");
}
__device__ __forceinline__ void p0_convert_item(Frame& F, int it, LAS float* scr) {
    if (it < 128) { const int g = it >> 5, r = it & 31, kb = r >> 3, nb = r & 7;
        p0_transpose_item(in_ptr(I_POOLW) + (size_t)g * 65536, 256, 64 * kb, 32 * nb, (bf16*)(F.ws + WS_WPOOL), 256, g * 256 + 32 * nb, scr, F.lane); return; }
    it -= 128;
    if (it < 1536) { const int kb = it / 96, nb = it % 96; p0_transpose_item(in_ptr(I_WQKV), 3072, 64 * kb, 32 * nb, (bf16*)(F.ws + WS_WQKV), 1024, 32 * nb, scr, F.lane); return; }
    it -= 1536;
    if (it < 512) { const int kb = it / 32, nb = it % 32; p0_transpose_item(in_ptr(I_WO), 1024, 64 * kb, 32 * nb, (bf16*)(F.ws + WS_WO), 1024, 32 * nb, scr, F.lane); return; }
    it -= 512;
    if (it < 5632) { const int l = it / 2816, r = it % 2816, kb = r / 176, nb = r % 176; const int n0 = 32 * nb;
        const int half = n0 >= DFF ? 1 : 0, nn = n0 - half * DFF; const int drow = 256 * (nn >> 7) + 128 * half + (nn & 127);
        p0_transpose_item(in_ptr(I_WUP) + (size_t)l * D * NUP, NUP, 64 * kb, n0, (bf16*)(F.ws + WS_WUP) + (size_t)l * NUP * D, 1024, drow, scr, F.lane); return; }
    it -= 5632;
    { const int l = it / 1408, r = it % 1408, kb = r / 32, nb = r % 32;
      p0_transpose_item(in_ptr(I_WDOWN) + (size_t)l * DFF * D, D, 64 * kb, 32 * nb, (bf16*)(F.ws + WS_WDN) + (size_t)l * D * DFF, DFF, 32 * nb, scr, F.lane); }
}
constexpr int N_CONV_ITEMS = 128 + 1536 + 512 + 5632 + 2816;
__device__ __forceinline__ void p0_prologue(Frame& F) {
    const int bid = blockIdx.x;
    float* mods = (float*)(F.ws + WS_MODS);
    if (bid < 192) {
        const float* pc = in_ptr(I_C); const float* pcc = in_ptr(I_CCTX); const float* padaw = in_ptr(I_ADAW); const float* padab = in_ptr(I_ADAB);
        const int l = bid / 96, ch = bid % 96, col = 64 * ch + F.lane, kb = 128 * F.wave;
        float cv[3][2];
#pragma unroll
        for (int h = 0; h < 2; ++h) { cv[0][h] = silu(pc[kb + 64 * h + F.lane]); cv[1][h] = silu(pc[D + kb + 64 * h + F.lane]); cv[2][h] = silu(pcc[kb + 64 * h + F.lane]); }
        const float* W = padaw + (size_t)l * D * ADA + (size_t)kb * ADA + col;
        float a0 = 0.f, a1 = 0.f, a2 = 0.f;
#pragma unroll
        for (int h = 0; h < 2; ++h)
#pragma unroll 16
            for (int kk = 0; kk < 64; ++kk) {
                const float w = W[(size_t)(64 * h + kk) * ADA];
                a0 += __builtin_bit_cast(float, __builtin_amdgcn_readlane(__builtin_bit_cast(int, cv[0][h]), kk)) * w;
                a1 += __builtin_bit_cast(float, __builtin_amdgcn_readlane(__builtin_bit_cast(int, cv[1][h]), kk)) * w;
                a2 += __builtin_bit_cast(float, __builtin_amdgcn_readlane(__builtin_bit_cast(int, cv[2][h]), kk)) * w;
            }
        LAS float* red = (LAS float*)(F.lds + RING_OFF);
        red[(F.wave * 3 + 0) * 64 + F.lane] = a0; red[(F.wave * 3 + 1) * 64 + F.lane] = a1; red[(F.wave * 3 + 2) * 64 + F.lane] = a2;
        __syncthreads();
        if (F.tid < 192) { const int s = F.tid >> 6, ln = F.tid & 63; float v = padab[l * ADA + 64 * ch + ln];
#pragma unroll
            for (int w = 0; w < 8; ++w) v += red[(w * 3 + s) * 64 + ln];
            mods[(size_t)(l * 3 + s) * ADA + 64 * ch + ln] = v; }
        __syncthreads();
    } else if (bid == 255) {
        float* T = (float*)(F.ws + WS_RPB); const float* prpb = in_ptr(I_RPB);
        for (int i = F.tid; i < 16 * 15 * 64; i += NWAVES * 64) { const int j = i & 63, hd = i >> 6; const int dc = j - 16; T[i] = (dc >= 0 && dc < 31) ? LOG2E * prpb[hd * 31 + dc] : 0.f; }
    }
    LAS float* scr = (LAS float*)(F.lds + RING_OFF + 8192 + F.wave * 12288);
    for (;;) {
        int it = 0;
        if (F.lane == 0) it = (int)__hip_atomic_fetch_add(F.ctl + CW_QUEUE, 1u, RLX_AGENT);
        it = __builtin_amdgcn_readfirstlane(it);
        if (it >= N_CONV_ITEMS) break;
        p0_convert_item(F, it, scr);
    }
}

__device__ __forceinline__ const float* rowp_in(const float* xm, const float* xc, int m) { return m < M_X ? xm + (size_t)m * D : xc + (size_t)(m - M_X) * D; }
__device__ __forceinline__ float* rowp_out(float* xm, float* xc, int m) { return m < M_X ? xm + (size_t)m * D : xc + (size_t)(m - M_X) * D; }

__device__ __forceinline__ void p1_pool_operand(Frame& F) {
    LAS float* NR = (LAS float*)(F.lds + RING_OFF);
    const float* mods = (const float*)(F.ws + WS_MODS);
    bf16* AD = (bf16*)(F.ws + WS_AD);
    const float* px = in_ptr(I_X); const float* pctx = in_ptr(I_CTX); const float* ppre = in_ptr(I_MIXPRE);
    for (int ch = F.vcu; ch < M_T / 16; ch += F.G) {
        const int row0 = 16 * ch;
        const int sq0 = row0 < M_X ? (row0 & ~8191) : (row0 & ~255), sq1 = sq0 + (row0 < M_X ? 8192 : 256);
        const int s = row0 < M_X ? (row0 >> 13) : 2;
        for (int j = F.wave; j < 31; j += NWAVES) {
            const int gr = row0 - 8 + j;
            if (gr >= sq0 && gr < sq1) {
                const f32x4* xr = (const f32x4*)rowp_in(px, pctx, gr) + F.lane;
                f32x4 v[4]; float ss = 0.f;
#pragma unroll
                for (int i = 0; i < 4; ++i) { v[i] = xr[64 * i]; ss += (v[i].x * v[i].x + v[i].y * v[i].y) + (v[i].z * v[i].z + v[i].w * v[i].w); }
                const float rstd = 1.0f / sqrtf(wave_sum(ss) * (1.0f / D) + EPS);
#pragma unroll
                for (int i = 0; i < 4; ++i) *(LAS f32x4*)(NR + j * 1024 + 256 * i + 4 * F.lane) = v[i] * rstd;
            }
        }
        __syncthreads();
        f32x4 gm[4];
#pragma unroll
        for (int i = 0; i < 4; ++i) { const int col = 256 * i + 4 * F.lane; const f32x4 g = *(const f32x4*)(ppre + col), sc = *(const f32x4*)(mods + (size_t)(0 * 3 + s) * ADA + 1 * D + col); gm[i] = g * (sc + 1.0f); }
#pragma unroll
        for (int rr = 0; rr < 2; ++rr) {
            const int t = row0 + F.wave + 8 * rr;
#pragma unroll
            for (int i = 0; i < 4; ++i) {
                const int half = 1 << i; const int lo = (t - half) > sq0 ? (t - half) : sq0, hi = (t + half) < sq1 ? (t + half) : sq1;
                f32x4 S = {0.f, 0.f, 0.f, 0.f};
                for (int r = lo; r < hi; ++r) S += *(LAS f32x4*)(NR + (r - row0 + 8) * 1024 + 256 * i + 4 * F.lane);
                const f32x4 cen = *(LAS f32x4*)(NR + (t - row0 + 8) * 1024 + 256 * i + 4 * F.lane);
                const f32x4 dd = (S * (1.0f / (float)(hi - lo)) - cen) * gm[i];
                v2u o; o.x = pk2(dd.x, dd.y); o.y = pk2(dd.z, dd.w);
                *(v2u*)(AD + (size_t)t * D + 256 * i + 4 * F.lane) = o;
            }
        }
        __syncthreads();
    }
}

struct RowPass {
    const float* Y; const float* colscale; const float* post_g; const float* mods_l; int gate_chunk;
    const float* xin_m; const float* xin_c; float* xout_m; float* xout_c;
    bf16* AD; const float* pre_g; const float* mods_n; int sh_chunk, sc_chunk;
    int nrows;
    int nslab; const float* slab1;
};
template <int NSLAB>
__device__ __forceinline__ void row_one(Frame& F, const RowPass& P, int m) {
    const int s = m < M_X ? (m >> 13) : 2;
    const f32x4* yr = (const f32x4*)(P.Y + (size_t)m * D) + F.lane;
    const f32x4* xr = (const f32x4*)rowp_in(P.xin_m, P.xin_c, m) + F.lane;
    f32x4 y[4], xv[4]; float ss = 0.f;
#pragma unroll
    for (int i = 0; i < 4; ++i) { y[i] = yr[64 * i]; xv[i] = xr[64 * i]; }
    if (NSLAB > 1) {
        f32x4 t[NSLAB > 1 ? NSLAB - 1 : 1][4];
#pragma unroll
        for (int j = 0; j < NSLAB - 1; ++j)
#pragma unroll
            for (int i = 0; i < 4; ++i) t[j][i] = *((const f32x4*)(P.slab1 + ((size_t)j * 512 + (m - M_X)) * D) + F.lane + 64 * i);
#pragma unroll
        for (int j = 0; j < NSLAB - 1; ++j)
#pragma unroll
            for (int i = 0; i < 4; ++i) y[i] += t[j][i];
    }
#pragma unroll
    for (int i = 0; i < 4; ++i) {
        if (P.colscale) y[i] = y[i] * *((const f32x4*)P.colscale + F.lane + 64 * i);
        ss += (y[i].x * y[i].x + y[i].y * y[i].y) + (y[i].z * y[i].z + y[i].w * y[i].w); }
    const float rstd = 1.0f / sqrtf(wave_sum(ss) * (1.0f / D) + EPS);
    float s2 = 0.f;
    f32x4* xo = (f32x4*)rowp_out(P.xout_m, P.xout_c, m) + F.lane;
#pragma unroll
    for (int i = 0; i < 4; ++i) {
        const f32x4 pg = *((const f32x4*)P.post_g + F.lane + 64 * i), gt = *((const f32x4*)(P.mods_l + (size_t)s * ADA + P.gate_chunk * D) + F.lane + 64 * i);
        xv[i] = xv[i] + gt * (y[i] * rstd * pg);
        xo[64 * i] = xv[i];
        s2 += (xv[i].x * xv[i].x + xv[i].y * xv[i].y) + (xv[i].z * xv[i].z + xv[i].w * xv[i].w);
    }
    if (P.AD) {
        const float rs2 = 1.0f / sqrtf(wave_sum(s2) * (1.0f / D) + EPS);
#pragma unroll
        for (int i = 0; i < 4; ++i) {
            const f32x4 g = *((const f32x4*)P.pre_g + F.lane + 64 * i), sc = *((const f32x4*)(P.mods_n + (size_t)s * ADA + P.sc_chunk * D) + F.lane + 64 * i), sh = *((const f32x4*)(P.mods_n + (size_t)s * ADA + P.sh_chunk * D) + F.lane + 64 * i);
            const f32x4 a = (xv[i] * rs2 * g) * (sc + 1.0f) + sh;
            v2u o; o.x = pk2(a.x, a.y); o.y = pk2(a.z, a.w);
            *(v2u*)(P.AD + (size_t)m * D + 256 * i + 4 * F.lane) = o;
        }
    }
}
__device__ __forceinline__ void row_pass(Frame& F, const RowPass& P) {
    const int gw = F.vcu * NWAVES + F.wave, NGW = F.G * NWAVES;
    const int rpw = (M_X + NGW - 1) / NGW;
    const int m0 = gw * rpw, m1 = (m0 + rpw) < M_X ? (m0 + rpw) : M_X;
    for (int m = m0; m < m1; ++m) row_one<1>(F, P, m);
    if (P.nrows > M_X) {
        for (int m = M_X + (NGW - 1 - gw); m < P.nrows; m += NGW) { if (P.nslab > 1) row_one<11>(F, P, m); else row_one<1>(F, P, m); }
    }
}

__device__ __forceinline__ void p8_vtranspose(Frame& F) {
    const bf16* V = (const bf16*)(F.ws + WS_V); bf16* VT = (bf16*)(F.ws + WS_VT); bf16* VCT = VT + (size_t)2 * 16 * 64 * 8192;
    LAS unsigned char* scr = F.lds + RING_OFF + F.wave * 16384;
    const int gw = F.vcu * NWAVES + F.wave, NGW = F.G * NWAVES;
    for (int it = gw; it < 4096 + 128; it += NGW) {
        int b, h, tb, seqlen, rowbase; bf16* dst;
        if (it < 4096) { b = it >> 11; h = (it >> 7) & 15; tb = it & 127; seqlen = 8192; rowbase = b * 8192; dst = VT + (size_t)(b * 16 + h) * 64 * 8192; }
        else { const int j = it - 4096; b = j >> 6; h = (j >> 2) & 15; tb = j & 3; seqlen = 256; rowbase = M_X + b * 256; dst = VCT + (size_t)(b * 16 + h) * 64 * 256; }
#pragma unroll
        for (int i = 0; i < 8; ++i) { const int row = 8 * i + (F.lane >> 3), chn = F.lane & 7;
            const v4u v = *(const v4u*)(V + (size_t)(rowbase + 64 * tb + row) * D + h * 64 + 8 * chn);
            *(LAS v4u*)(scr + row * 144 + chn * 16) = v; }
        LDS_WAIT(); asm volatile("" ::: "memory");
        const int tp = F.lane & 31, dd = F.lane >> 5;
#pragma unroll 8
        for (int i = 0; i < 32; ++i) { const int d = 2 * i + dd;
            const unsigned lo = *(LAS unsigned short*)(scr + (2 * tp) * 144 + 2 * d), hi = *(LAS unsigned short*)(scr + (2 * tp + 1) * 144 + 2 * d);
            *(unsigned*)(dst + (size_t)d * seqlen + 64 * tb + 2 * tp) = lo | (hi << 16); }
        LDS_WAIT(); asm volatile("" ::: "memory");
    }
}

__device__ __forceinline__ void p9_attention(Frame& F) {
    const bf16* Q = (const bf16*)(F.ws + WS_Q); const bf16* Kb = (const bf16*)(F.ws + WS_K);
    const bf16* VT = (const bf16*)(F.ws + WS_VT); const bf16* VCT = VT + (size_t)2 * 16 * 64 * 8192;
    bf16* O = (bf16*)(F.ws + WS_Q);
    const float* RT = (const float*)(F.ws + WS_RPB);
    LAS unsigned char* R = F.lds + RING_OFF;
    constexpr int VC_OFF = 9 * 64 * 128;
    constexpr int TB_OFF = 104 * 1024;
    { const int h0 = ((F.vcu * 8) >> 6) & 15; for (int i = F.tid; i < 15 * 64; i += NWAVES * 64) *(LAS float*)(R + TB_OFF + 4 * i) = RT[h0 * 15 * 64 + i]; }
    for (int itw = F.vcu * 8; itw < F.vcu * 8 + 8; ++itw) {
        int lane = F.lane; asm volatile("" : "+v"(lane));
        const int l15 = lane & 15, g = lane >> 4;
        const int rp = itw & 63, h = (itw >> 6) & 15, b = itw >> 10;
        const int r0 = 2 * rp, kr0 = (r0 - 4) < 0 ? 0 : ((r0 - 4) > 119 ? 119 : (r0 - 4));
        const int cb = F.wave & 3, r = r0 + (F.wave >> 2);
        const int s0 = (r - 4) < 0 ? 0 : ((r - 4) > 120 ? 120 : (r - 4));
        const int bs = cb == 0 ? 0 : (cb == 1 ? 8 : (cb == 2 ? 24 : 32));
        const int qc = 16 * cb + l15;
        const size_t tq = (size_t)b * 8192 + r * 64 + qc;
#pragma unroll 1
        for (int j = 0; j < 13; ++j) {
            const int pc = F.wave * 13 + j, kk = 8 * pc + (lane >> 3), p = lane & 7, c = p ^ (kk & 7);
            const size_t tok = kk < 576 ? (size_t)b * 8192 + (size_t)(kr0 + (kk >> 6)) * 64 + (kk & 63) : (size_t)M_X + b * 256 + (kk - 576);
            __builtin_amdgcn_global_load_lds((const unsigned*)(Kb + tok * D + h * 64 + 8 * c), (LAS unsigned*)(R + pc * 1024), 16, 0, 0);
        }
        bf16x8 qf[2];
#pragma unroll
        for (int ks = 0; ks < 2; ++ks) qf[ks] = *(const bf16x8*)(Q + tq * D + h * 64 + 32 * ks + 8 * g);
        __syncthreads();
        const int kap = 8 * (l15 >> 2) + (l15 & 3);
        unsigned ka[2][2], kc_[2][2];
#pragma unroll
        for (int tau = 0; tau < 2; ++tau)
#pragma unroll
            for (int ks = 0; ks < 2; ++ks) {
                ka[tau][ks] = (unsigned)((s0 - kr0) * 8192 + bs * 128 + (kap + 4 * tau) * 128 + (((4 * ks + g) ^ ((l15 & 3) + 4 * tau)) << 4)); asm volatile("" : "+v"(ka[tau][ks]));
                kc_[tau][ks] = (unsigned)(576 * 128 + (kap + 4 * tau) * 128 + (((4 * ks + g) ^ ((l15 & 3) + 4 * tau)) << 4)); asm volatile("" : "+v"(kc_[tau][ks])); }
        const int wst = (qc - 8) < 0 ? 0 : ((qc - 8) > 48 ? 48 : (qc - 8));
        float m1 = -3.0e38f, l1 = 0.f, m2 = -3.0e38f, l2 = 0.f;
        bf16x8 pb[16];
        {
            f32x4 sc[8][2];
#pragma unroll
            for (int p = 0; p < 8; ++p) {
#pragma unroll
                for (int tau = 0; tau < 2; ++tau) {
                    const bf16x8 k0 = *(const LAS bf16x8*)(R + ka[tau][0] + p * 8192), k1 = *(const LAS bf16x8*)(R + ka[tau][1] + p * 8192);
                    f32x4 a = {0.f, 0.f, 0.f, 0.f};
                    a = __builtin_amdgcn_mfma_f32_16x16x32_bf16(k0, qf[0], a, 0, 0, 0);
                    a = __builtin_amdgcn_mfma_f32_16x16x32_bf16(k1, qf[1], a, 0, 0, 0);
                    sc[p][tau] = a;
                }
                if (p & 1) __builtin_amdgcn_sched_barrier(0);
            }
#pragma unroll
            for (int p = 0; p < 8; ++p) {
                const int dr = s0 + p - r + 7;
                const LAS float* rt = (const LAS float*)(R + TB_OFF) + dr * 64 + 16 + 15 - qc + bs + 8 * g;
#pragma unroll
                for (int tau = 0; tau < 2; ++tau)
#pragma unroll
                    for (int rho = 0; rho < 4; ++rho) {
                        const int e = 4 * tau + rho, kc = bs + 8 * g + e;
                        const bool valid = (kc >= wst) && (kc < wst + 16);
                        const float bv = rt[e];
                        const float v = valid ? sc[p][tau][rho] + bv : -1.0e30f;
                        sc[p][tau][rho] = v; m1 = fmaxf(m1, v);
                    }
            }
            m1 = fmaxf(m1, __shfl_xor(m1, 16)); m1 = fmaxf(m1, __shfl_xor(m1, 32));
#pragma unroll
            for (int p = 0; p < 8; ++p) {
                float pv[8];
#pragma unroll
                for (int tau = 0; tau < 2; ++tau)
#pragma unroll
                    for (int rho = 0; rho < 4; ++rho) { const float e = __builtin_amdgcn_exp2f(sc[p][tau][rho] - m1); pv[4 * tau + rho] = e; l1 += e; }
                v4u w; w.x = pg8::cvt_pk_bf16(pv[0], pv[1]); w.y = pg8::cvt_pk_bf16(pv[2], pv[3]); w.z = pg8::cvt_pk_bf16(pv[4], pv[5]); w.w = pg8::cvt_pk_bf16(pv[6], pv[7]);
                pb[p] = __builtin_bit_cast(bf16x8, w);
            }
        }
        {
            f32x4 sc[8][2];
#pragma unroll
            for (int p = 0; p < 8; ++p) {
#pragma unroll
                for (int tau = 0; tau < 2; ++tau) {
                    const bf16x8 k0 = *(const LAS bf16x8*)(R + kc_[tau][0] + p * 4096), k1 = *(const LAS bf16x8*)(R + kc_[tau][1] + p * 4096);
                    f32x4 a = {0.f, 0.f, 0.f, 0.f};
                    a = __builtin_amdgcn_mfma_f32_16x16x32_bf16(k0, qf[0], a, 0, 0, 0);
                    a = __builtin_amdgcn_mfma_f32_16x16x32_bf16(k1, qf[1], a, 0, 0, 0);
                    sc[p][tau] = a;
                }
                if (p & 1) __builtin_amdgcn_sched_barrier(0);
            }
            __syncthreads();
#pragma unroll 1
            for (int j = 0; j < 9; ++j) {
                const int pc = F.wave * 9 + j, rr = 8 * pc + (lane >> 3), d = rr & 63, p = lane & 7, c = p ^ (d & 7);
                __builtin_amdgcn_global_load_lds((const unsigned*)(VT + ((size_t)(b * 16 + h) * 64 + d) * 8192 + (size_t)(kr0 + (rr >> 6)) * 64 + 8 * c), (LAS unsigned*)(R + pc * 1024), 16, 0, 0);
            }
#pragma unroll 1
            for (int j = 0; j < 4; ++j) {
                const int pc = F.wave * 4 + j, d = 2 * pc + (lane >> 5), p = lane & 31, c = p ^ (d & 7);
                __builtin_amdgcn_global_load_lds((const unsigned*)(VCT + ((size_t)(b * 16 + h) * 64 + d) * 256 + 8 * c), (LAS unsigned*)(R + VC_OFF + pc * 1024), 16, 0, 0);
            }
#pragma unroll
            for (int p = 0; p < 8; ++p)
#pragma unroll
                for (int tau = 0; tau < 2; ++tau)
#pragma unroll
                    for (int rho = 0; rho < 4; ++rho) m2 = fmaxf(m2, sc[p][tau][rho]);
            m2 = fmaxf(m2, __shfl_xor(m2, 16)); m2 = fmaxf(m2, __shfl_xor(m2, 32));
#pragma unroll
            for (int p = 0; p < 8; ++p) {
                float pv[8];
#pragma unroll
                for (int tau = 0; tau < 2; ++tau)
#pragma unroll
                    for (int rho = 0; rho < 4; ++rho) { const float e = __builtin_amdgcn_exp2f(sc[p][tau][rho] - m2); pv[4 * tau + rho] = e; l2 += e; }
                v4u w; w.x = pg8::cvt_pk_bf16(pv[0], pv[1]); w.y = pg8::cvt_pk_bf16(pv[2], pv[3]); w.z = pg8::cvt_pk_bf16(pv[4], pv[5]); w.w = pg8::cvt_pk_bf16(pv[6], pv[7]);
                pb[8 + p] = __builtin_bit_cast(bf16x8, w);
            }
        }
        l1 += __shfl_xor(l1, 16); l1 += __shfl_xor(l1, 32); l2 += __shfl_xor(l2, 16); l2 += __shfl_xor(l2, 32);
        const float mm = fmaxf(m1, m2), f1 = __builtin_amdgcn_exp2f(m1 - mm), f2 = __builtin_amdgcn_exp2f(m2 - mm);
        const float lsum = l1 * f1 + l2 * f2;
        __syncthreads();
        f32x4 o[4], o2[4];
#pragma unroll
        for (int dt = 0; dt < 4; ++dt) { o[dt] = (f32x4){0.f, 0.f, 0.f, 0.f}; o2[dt] = (f32x4){0.f, 0.f, 0.f, 0.f}; }
        unsigned va = (unsigned)((s0 - kr0) * 8192 + l15 * 128 + ((((bs >> 3) + g) ^ (l15 & 7)) << 4)); asm volatile("" : "+v"(va));
        unsigned vc0 = (unsigned)(VC_OFF + l15 * 512 + ((g ^ (l15 & 7)) << 4)), vc1 = (unsigned)(VC_OFF + l15 * 512 + (((4 + g) ^ (l15 & 7)) << 4)); asm volatile("" : "+v"(vc0), "+v"(vc1));
#pragma unroll
        for (int p = 0; p < 8; ++p) {
#pragma unroll
            for (int dt = 0; dt < 4; ++dt) {
                const bf16x8 vf = *(const LAS bf16x8*)(R + va + p * 8192 + dt * 2048);
                o[dt] = __builtin_amdgcn_mfma_f32_16x16x32_bf16(vf, pb[p], o[dt], 0, 0, 0);
            }
            if (p & 1) __builtin_amdgcn_sched_barrier(0);
        }
#pragma unroll
        for (int p = 0; p < 8; ++p) {
#pragma unroll
            for (int dt = 0; dt < 4; ++dt) {
                const bf16x8 vf = *(const LAS bf16x8*)(R + ((p & 1) ? vc1 : vc0) + dt * 8192 + (p >> 1) * 128);
                o2[dt] = __builtin_amdgcn_mfma_f32_16x16x32_bf16(vf, pb[8 + p], o2[dt], 0, 0, 0);
            }
            if (p & 1) __builtin_amdgcn_sched_barrier(0);
        }
#pragma unroll
        for (int dt = 0; dt < 4; ++dt) o[dt] = o[dt] * f1 + o2[dt] * f2;
        const float inv = 1.0f / lsum;
#pragma unroll
        for (int dt = 0; dt < 4; ++dt) { v2u w; w.x = pk2(o[dt][0] * inv, o[dt][1] * inv); w.y = pk2(o[dt][2] * inv, o[dt][3] * inv);
            *(v2u*)(O + tq * D + h * 64 + 16 * dt + 4 * g) = w; }
        __syncthreads();
    }
}

constexpr int N_PHASES = 15;
__global__ void __launch_bounds__(NWAVES * 64, 2) dit_fwd(Args args) {
    extern __shared__ __attribute__((aligned(16))) unsigned char lds[];
    Frame F;
    F.lds = (LAS unsigned char*)lds;
    F.tid = threadIdx.x; F.lane = F.tid & 63; F.wave = __builtin_amdgcn_readfirstlane(F.tid >> 6);
    F.G = gridDim.x; { const int bx = blockIdx.x; F.vcu = (F.G % 8 == 0) ? (bx % 8) * (F.G / 8) + bx / 8 : bx; }
    unsigned char* ws = args.ws; F.ws = ws; F.out = args.out;
    F.ctl = (gu32*)(ws + WS_CTL);
    volatile LAS unsigned* MISC = (volatile LAS unsigned*)(F.lds + MISC_OFF);
    for (int u = F.tid; u < (LDS_BYTES - LDSCTL_OFF) / 4; u += NWAVES * 64) ((LAS unsigned*)(F.lds + LDSCTL_OFF))[u] = 0u;
    __syncthreads();
    const int lo = args.ph_lo, hi = args.ph_hi;
    XcdBarrier bar; bar.bar = (unsigned*)(F.ctl + CW_BAR); bar.x = 0; bar.st = nullptr;
    if (hi - lo > 1) bar = xcd_barrier_post((unsigned*)(F.ctl + CW_BAR), MISC + 8);
#ifndef PHASE_MASK
#define PHASE_MASK 0x7fff
#endif
#define IN(k) (((PHASE_MASK >> (k)) & 1) && lo <= (k) && (k) < hi)
#ifdef PROBE_A
    unsigned long long tprev = __builtin_amdgcn_s_memrealtime(); float dA = 0.f, dB = 0.f;
#define SEAM(k) do { if (IN(k) && IN((k) + 1)) xcd_barrier(bar); { const unsigned long long tn = __builtin_amdgcn_s_memrealtime(); if ((PROBE_A >> (k)) & 1) dA += (float)(tn - tprev) * 0.01f; if ((PROBE_B >> (k)) & 1) dB += (float)(tn - tprev) * 0.01f; tprev = tn; } } while (0)
#else
#define SEAM(k) do { if (IN(k) && IN((k) + 1)) xcd_barrier(bar); } while (0)
#endif
#define mods ((float*)(ws + WS_MODS))
#define AD ((bf16*)(ws + WS_AD))
#define Y ((float*)(ws + WS_Y))
#define Gb ((bf16*)(ws + WS_G))
#define XC ((float*)(ws + WS_XC))
    const int c = (int)blockIdx.x;

    if (IN(0)) { p0_prologue(F); SEAM(0); }
    if (IN(1)) { p1_pool_operand(F); SEAM(1); }
    if (IN(2)) {
        pg8::Gemm g{AD, (const bf16*)(ws + WS_WPOOL), D, 256, 256, 256};
        pg8::Sched S{F.G, c, 0, 66, 4, 0, 0, 0, 0, 4, 1};
        pg8::EpiF32 E{Y, D, nullptr, nullptr, 0};
        pg8::gemm_phase<pg8::EpiF32>(F.lds + RING_OFF, g, S, E);
        SEAM(2);
    }
    if (IN(3)) {
        RowPass P{Y, in_ptr(I_POOLS), in_ptr(I_MIXPOST), mods, 2, in_ptr(I_X), in_ptr(I_CTX), F.out, XC, AD, in_ptr(I_FFNPRE), mods, 3, 4, M_T, 1, nullptr};
        row_pass(F, P); SEAM(3);
    }
    if (IN(4)) {
        pg8::Gemm g{AD, (const bf16*)(ws + WS_WUP), D, D, D, 0};
        pg8::Sched S{F.G, c, 1, 68, 22, 0, 0, 0, 0, 16, 1};
        pg8::EpiConvAct E{Gb, in_ptr(I_CONVW), in_ptr(I_CONVB)};
        pg8::gemm_phase<pg8::EpiConvAct>(F.lds + RING_OFF, g, S, E);
        SEAM(4);
    }
    if (IN(5)) {
        pg8::Gemm g{Gb, (const bf16*)(ws + WS_WDN), DFF, DFF, DFF, 0};
        pg8::Sched S{F.G, c, 0, 64, 4, 2, 4, 64, 0, 44, 11};
        pg8::EpiF32 E{Y, D, Y + (size_t)M_X * D, (float*)(ws + WS_SLAB), M_X};
        pg8::gemm_phase<pg8::EpiF32>(F.lds + RING_OFF, g, S, E);
        SEAM(5);
    }
    if (IN(6)) {
        RowPass P{Y, nullptr, in_ptr(I_FFNPOST), mods, 5, F.out, XC, F.out, XC, AD, in_ptr(I_MIXPRE) + D, mods + 3 * ADA, 0, 1, M_T, 11, (const float*)(ws + WS_SLAB)};
        row_pass(F, P); SEAM(6);
    }
    if (IN(7)) {
        pg8::Gemm g{AD, (const bf16*)(ws + WS_WQKV), D, D, D, 0};
        pg8::Sched S{F.G, c, 0, 64, 12, 2, 8, 64, 4, 16, 1};
        pg8::EpiQKV E{(bf16*)(ws + WS_Q), ((long)WS_K - (long)WS_Q) / 2, ((long)WS_V - (long)WS_K) / 2, QSCALE};
        pg8::gemm_phase<pg8::EpiQKV>(F.lds + RING_OFF, g, S, E);
        SEAM(7);
    }
    if (IN(8)) { p8_vtranspose(F); SEAM(8); }
    if (IN(9)) { p9_attention(F); SEAM(9); }
    if (IN(10)) {
        pg8::Gemm g{(const bf16*)(ws + WS_Q), (const bf16*)(ws + WS_WO), D, D, D, 0};
        pg8::Sched S{F.G, c, 0, 64, 4, 0, 0, 0, 0, 16, 1};
        pg8::EpiF32 E{Y, D, nullptr, nullptr, 0};
        pg8::gemm_phase<pg8::EpiF32>(F.lds + RING_OFF, g, S, E);
        SEAM(10);
    }
    if (IN(11)) {
        RowPass P{Y, nullptr, in_ptr(I_MIXPOST) + D, mods + 3 * ADA, 2, F.out, XC, F.out, XC, AD, in_ptr(I_FFNPRE) + D, mods + 3 * ADA, 3, 4, M_X, 1, nullptr};
        row_pass(F, P); SEAM(11);
    }
    if (IN(12)) {
        pg8::Gemm g{AD, (const bf16*)(ws + WS_WUP) + (size_t)NUP * D, D, D, D, 0};
        pg8::Sched S{F.G, c, 1, 66, 22, 0, 0, 0, 0, 16, 1};
        pg8::EpiConvAct E{Gb, in_ptr(I_CONVW) + 3 * NUP, in_ptr(I_CONVB) + NUP};
        pg8::gemm_phase<pg8::EpiConvAct>(F.lds + RING_OFF, g, S, E);
        SEAM(12);
    }
    if (IN(13)) {
        pg8::Gemm g{Gb, (const bf16*)(ws + WS_WDN) + (size_t)D * DFF, DFF, DFF, DFF, 0};
        pg8::Sched S{F.G, c, 0, 64, 4, 0, 0, 0, 0, 44, 1};
        pg8::EpiF32 E{Y, D, nullptr, nullptr, 0};
        pg8::gemm_phase<pg8::EpiF32>(F.lds + RING_OFF, g, S, E);
        SEAM(13);
    }
    if (IN(14)) {
        RowPass P{Y, nullptr, in_ptr(I_FFNPOST) + D, mods + 3 * ADA, 5, F.out, XC, F.out, XC, nullptr, nullptr, nullptr, 0, 0, M_X, 1, nullptr};
        row_pass(F, P);
    }
#ifdef PROBE_A
    { const unsigned long long tn = __builtin_amdgcn_s_memrealtime(); if ((PROBE_A >> 14) & 1) dA += (float)(tn - tprev) * 0.01f; if ((PROBE_B >> 14) & 1) dB += (float)(tn - tprev) * 0.01f;
      if (blockIdx.x == 0) {
          const float extra_us = 10.f * dA + 8000.f * floorf(dB * 0.1f + 0.5f);
          const unsigned long long ticks = (unsigned long long)(extra_us * 100.f);
          while (__builtin_amdgcn_s_memrealtime() - tn < ticks) __builtin_amdgcn_s_sleep(20);
      } }
#endif
#undef IN
#undef SEAM
#undef mods
#undef AD
#undef Y
#undef Gb
#undef XC
}

extern "C" void kernel_launch(void* const* d_in, const int* in_sizes, int n_in, void* d_out, int out_size, void* d_ws, size_t ws_size, hipStream_t stream) {
    static int grid = 0;
    if (grid == 0) {
        if (n_in != 19 || in_sizes[0] != M_X * D || out_size != M_X * D || ws_size < WS_END) { fprintf(stderr, "kernel_launch: unexpected shapes (n_in %d, in0 %d, out %d, ws %zu)\n", n_in, n_in > 0 ? in_sizes[0] : -1, out_size, ws_size); grid = -1; return; }
        int dev = 0, cus = 0, per_cu = 0;
        if (hipGetDevice(&dev) != hipSuccess || hipDeviceGetAttribute(&cus, hipDeviceAttributeMultiprocessorCount, dev) != hipSuccess) { grid = -1; return; }
        if (hipFuncSetAttribute((const void*)dit_fwd, hipFuncAttributeMaxDynamicSharedMemorySize, LDS_BYTES) != hipSuccess) { fprintf(stderr, "kernel_launch: hipFuncSetAttribute failed\n"); grid = -1; return; }
        if (hipOccupancyMaxActiveBlocksPerMultiprocessor(&per_cu, (const void*)dit_fwd, NWAVES * 64, LDS_BYTES) != hipSuccess || per_cu < 1) { fprintf(stderr, "kernel_launch: occupancy query reports %d blocks per CU\n", per_cu); }
        (void)hipGetLastError();
        grid = cus;
    }
    if (grid < 0) return;
    if (hipMemsetAsync((char*)d_ws + WS_CTL, 0, CTL_ZERO_BYTES, stream) != hipSuccess) { fprintf(stderr, "kernel_launch: memset failed\n"); return; }
    Args a{};
    for (int i = 0; i < 19; ++i) a.in[i] = (const float*)d_in[i];
    a.out = (float*)d_out; a.ws = (unsigned char*)d_ws;
#if MK_N_LAUNCHES == 1
    a.ph_lo = 0; a.ph_hi = N_PHASES;
    hipLaunchKernelGGL(dit_fwd, dim3(grid), dim3(NWAVES * 64), LDS_BYTES, stream, a);
#else
    for (int p = 0; p < N_PHASES; ++p) { a.ph_lo = p; a.ph_hi = p + 1; hipLaunchKernelGGL(dit_fwd, dim3(grid), dim3(NWAVES * 64), LDS_BYTES, stream, a); }
#endif
    const hipError_t le = hipPeekAtLastError();
    if (le != hipSuccess) fprintf(stderr, "kernel_launch: launch failed: %s (grid %d)\n", hipGetErrorName(le), grid);
}
```
